# Optimizing an MI355X kernel written in HIP

```python
import math
import jax, jax.numpy as jnp
from jax import lax
import numpy as np

D_MODEL = 2048
BATCH = 16
SEQ = 2048
DEPTH = 4

N_MEM = 256
HEAD_DIM = 128
DIFF_WIDTH = D_MODEL // 2
N_DIFF_HEADS = DIFF_WIDTH // HEAD_DIM
DIFF_QK_DIM = HEAD_DIM // 2
DIFF_QK_WIDTH = N_DIFF_HEADS * 2 * DIFF_QK_DIM
Q_BLOCK = 128
SGU_WIDTH = D_MODEL // 2
SGU_CHUNK = 128
SGU_GROUPS = SGU_WIDTH // HEAD_DIM
SGU_GROUP_DIM = SGU_WIDTH // SGU_GROUPS
CONV_WIDTH = D_MODEL // 2
CONV_TAPS = 3
N_BRANCHES = 3
MIX_SPLIT_SIZES = (DIFF_QK_WIDTH, DIFF_QK_WIDTH, DIFF_WIDTH,
                   SGU_WIDTH, SGU_WIDTH,
                   CONV_WIDTH, CONV_WIDTH, CONV_WIDTH,
                   N_BRANCHES * D_MODEL)
MIX_IN_WIDTH = sum(MIX_SPLIT_SIZES)
N_MEM_HEADS = 4
MEM_HEAD_DIM = 128
MEM_WIDTH = N_MEM_HEADS * MEM_HEAD_DIM
D_FF = ((8 * D_MODEL // 3 + 255) // 256) * 256
RMS_EPS = 1e-6

kernel_name = 'hybrid_diffattn_sgu_shortconv_macaron'


def rms_norm(x, g, eps=RMS_EPS):
    xf = x.astype(jnp.float32)
    y = xf * lax.rsqrt(jnp.mean(xf * xf, axis=-1, keepdims=True) + eps)
    return (y * g.astype(jnp.float32)).astype(x.dtype)


def swiglu(n, w_in, w_out):
    a, b = jnp.split(n @ w_in, 2, axis=-1)
    return (jax.nn.silu(a) * b) @ w_out


def alibi_slopes(n_heads):
    return 2.0 ** (-8.0 * jnp.arange(1, n_heads + 1, dtype=jnp.float32) / n_heads)


def diff_attention(q, k, v, lam, slopes):
    bsz, seq, n_heads, _, dq = q.shape
    n_blocks = seq // Q_BLOCK
    q = q * (1.0 / math.sqrt(dq))
    q_blocks = q.reshape(bsz, n_blocks, Q_BLOCK, n_heads, 2, dq).transpose(1, 0, 3, 4, 2, 5)
    k_t = k.transpose(0, 2, 3, 1, 4)
    v_t = v.transpose(0, 2, 1, 3)
    k_pos = jnp.arange(seq)

    def block(args):
        q_blk, start = args
        q_pos = start + jnp.arange(Q_BLOCK)
        dist = q_pos[:, None] - k_pos[None, :]
        bias = -slopes[:, None, None] * dist.astype(jnp.float32)
        s = jnp.einsum('bhiqd,bhikd->bhiqk', q_blk, k_t,
                       preferred_element_type=jnp.float32)
        s = jnp.where(dist >= 0, s + bias[:, None], -jnp.inf)
        p = jax.nn.softmax(s, axis=-1)
        w = p[:, :, 0] - lam * p[:, :, 1]
        return jnp.einsum('bhqk,bhkd->bhqd', w.astype(v_t.dtype), v_t)

    starts = jnp.arange(n_blocks) * Q_BLOCK
    o = lax.map(block, (q_blocks, starts))
    return o.transpose(1, 0, 3, 2, 4).reshape(bsz, seq, n_heads, v.shape[-1])


def hybrid_mixer(n, lam, lam_init, w_in, diff_subln, diff_w_out, sgu_norm, sgu_w_s, sgu_b,
                 sgu_w_out, conv_w, conv_w_out, w_o):
    bsz, seq, _ = n.shape
    offsets = np.cumsum(MIX_SPLIT_SIZES)[:-1].tolist()
    q, k, v, u, g_v, c_b, c_c, c_x, gate_logits = jnp.split(n @ w_in, offsets, axis=-1)

    q = q.reshape(bsz, seq, N_DIFF_HEADS, 2, DIFF_QK_DIM)
    k = k.reshape(bsz, seq, N_DIFF_HEADS, 2, DIFF_QK_DIM)
    v = v.reshape(bsz, seq, N_DIFF_HEADS, HEAD_DIM)
    o = diff_attention(q, k, v, lam, alibi_slopes(N_DIFF_HEADS))
    y_a = (rms_norm(o, diff_subln) * (1.0 - lam_init)).reshape(bsz, seq, DIFF_WIDTH)

    u = jax.nn.gelu(u, approximate=False)
    g_v = rms_norm(jax.nn.gelu(g_v, approximate=False), sgu_norm)
    g_v = g_v.reshape(bsz, seq // SGU_CHUNK, SGU_CHUNK, SGU_GROUPS, SGU_GROUP_DIM)
    w_s = jnp.tril(sgu_w_s)
    mixed = jnp.einsum('gts,bcsgd->bctgd', w_s, g_v) + sgu_b.T[None, None, :, :, None]
    y_b = u * mixed.reshape(bsz, seq, SGU_WIDTH)

    z = c_c * c_x
    zp = jnp.pad(z, ((0, 0), (CONV_TAPS - 1, 0), (0, 0)))
    conv = conv_w[0] * zp[:, 0:seq] + conv_w[1] * zp[:, 1:seq + 1] + conv_w[2] * zp[:, 2:seq + 2]
    y_c = c_b * conv

    gates = jax.nn.sigmoid(gate_logits.astype(jnp.float32)).astype(n.dtype)
    gates = gates.reshape(bsz, seq, N_BRANCHES, D_MODEL)
    merged = (gates[:, :, 0] * (y_a @ diff_w_out)
              + gates[:, :, 1] * (y_b @ sgu_w_out)
              + gates[:, :, 2] * (y_c @ conv_w_out))
    return merged @ w_o


def memory_attention(n, mem_n, w_q, w_kv, w_o):
    bsz, seq, _ = n.shape
    q = (n @ w_q).reshape(bsz, seq, N_MEM_HEADS, MEM_HEAD_DIM)
    kv = (mem_n @ w_kv).reshape(bsz, mem_n.shape[1], 2, N_MEM_HEADS, MEM_HEAD_DIM)
    k, v = kv[:, :, 0], kv[:, :, 1]
    s = jnp.einsum('bqhd,bkhd->bhqk', q, k, preferred_element_type=jnp.float32)
    p = jax.nn.softmax(s * (1.0 / math.sqrt(MEM_HEAD_DIM)), axis=-1)
    o = jnp.einsum('bhqk,bkhd->bqhd', p.astype(v.dtype), v).reshape(bsz, seq, MEM_WIDTH)
    return o @ w_o


def setup_inputs(seed: int = 0) -> dict:
    key = jax.random.key(seed)
    ks = iter(jax.random.split(key, 32))
    L = DEPTH

    def dense(shape, fan_in):
        return jax.random.normal(next(ks), shape, jnp.float32) * (fan_in ** -0.5)

    def gain(shape):
        return 1.0 + 0.02 * jax.random.normal(next(ks), shape, jnp.float32)

    return {
        'x': jax.random.normal(next(ks), (BATCH, SEQ, D_MODEL), jnp.float32),
        'mem': jax.random.normal(next(ks), (BATCH, N_MEM, D_MODEL), jnp.float32),
        'ffn1_norm': gain((L, D_MODEL)),
        'ffn1_w_in': dense((L, D_MODEL, 2 * D_FF), D_MODEL),
        'ffn1_w_out': dense((L, D_FF, D_MODEL), D_FF),
        'mix_norm': gain((L, D_MODEL)),
        'mix_w_in': dense((L, D_MODEL, MIX_IN_WIDTH), D_MODEL),
        'diff_lambda': 0.1 * jax.random.normal(next(ks), (L, 4, DIFF_QK_DIM), jnp.float32),
        'diff_subln': gain((L, HEAD_DIM)),
        'diff_w_out': dense((L, DIFF_WIDTH, D_MODEL), DIFF_WIDTH),
        'sgu_norm': gain((L, SGU_WIDTH)),
        'sgu_w_s': dense((L, SGU_GROUPS, SGU_CHUNK, SGU_CHUNK), SGU_CHUNK),
        'sgu_b': gain((L, SGU_GROUPS, SGU_CHUNK)),
        'sgu_w_out': dense((L, SGU_WIDTH, D_MODEL), SGU_WIDTH),
        'conv_w': dense((L, CONV_TAPS, CONV_WIDTH), CONV_TAPS),
        'conv_w_out': dense((L, CONV_WIDTH, D_MODEL), CONV_WIDTH),
        'mix_w_o': dense((L, D_MODEL, D_MODEL), D_MODEL),
        'xattn_norm': gain((L, D_MODEL)),
        'mem_norm': gain((L, D_MODEL)),
        'xattn_w_q': dense((L, D_MODEL, MEM_WIDTH), D_MODEL),
        'xattn_w_kv': dense((L, D_MODEL, 2 * MEM_WIDTH), D_MODEL),
        'xattn_w_o': dense((L, MEM_WIDTH, D_MODEL), MEM_WIDTH),
        'ffn2_norm': gain((L, D_MODEL)),
        'ffn2_w_in': dense((L, D_MODEL, 2 * D_FF), D_MODEL),
        'ffn2_w_out': dense((L, D_FF, D_MODEL), D_FF),
        'final_norm': gain((D_MODEL,)),
    }


def reference(x, mem, ffn1_norm, ffn1_w_in, ffn1_w_out, mix_norm, mix_w_in, diff_lambda,
              diff_subln, diff_w_out, sgu_norm, sgu_w_s, sgu_b, sgu_w_out, conv_w, conv_w_out,
              mix_w_o, xattn_norm, mem_norm, xattn_w_q, xattn_w_kv, xattn_w_o, ffn2_norm,
              ffn2_w_in, ffn2_w_out, final_norm):
    h = x
    for l in range(DEPTH):
        lam_init = 0.8 - 0.6 * math.exp(-0.3 * l)
        lp = diff_lambda[l].astype(jnp.float32)
        lam = jnp.exp(jnp.sum(lp[0] * lp[1])) - jnp.exp(jnp.sum(lp[2] * lp[3])) + lam_init

        h = h + 0.5 * swiglu(rms_norm(h, ffn1_norm[l]), ffn1_w_in[l], ffn1_w_out[l])
        h = h + hybrid_mixer(rms_norm(h, mix_norm[l]), lam, lam_init, mix_w_in[l], diff_subln[l],
                             diff_w_out[l], sgu_norm[l], sgu_w_s[l], sgu_b[l], sgu_w_out[l],
                             conv_w[l], conv_w_out[l], mix_w_o[l])
        h = h + memory_attention(rms_norm(h, xattn_norm[l]), rms_norm(mem, mem_norm[l]),
                                 xattn_w_q[l], xattn_w_kv[l], xattn_w_o[l])
        h = h + 0.5 * swiglu(rms_norm(h, ffn2_norm[l]), ffn2_w_in[l], ffn2_w_out[l])
    return rms_norm(h, final_norm)
```

```cpp
#include <hip/hip_runtime.h>
#include <hip/hip_bf16.h>
#include <cstdio>
#include <cstdint>
#include <cmath>
namespace pg8 {
#define PG8_LAS __attribute__((address_space(3)))
typedef unsigned short bf16_t;
typedef short bf16x8 __attribute__((ext_vector_type(8)));
typedef float f32x4 __attribute__((ext_vector_type(4)));
typedef unsigned u32x4 __attribute__((ext_vector_type(4)));
constexpr int BM = 256, BK = 64, HALF = 128, HTB = HALF * BK * 2  , STAGE_BYTES = 8 * HTB, NXCD = 8, WGM = 8;

__host__ __device__ __forceinline__ int lds_byte(int r, int c) { const int st = (r >> 4) * 2 + (c >> 5), rr = r & 15, cc = c & 31, ob = rr * 64 + cc * 2; return st * 1024 + (ob ^ (((ob >> 9) & 1) << 5)); }
__host__ __device__ __forceinline__ void stage_rc(int b, int& R, int& C) { const int st = b / 1024, sb = b % 1024, swz = sb ^ (((sb >> 9) & 1) << 5); R = (st >> 1) * 16 + swz / 64; C = (st & 1) * 32 + (swz % 64) / 2; }
__host__ __device__ __forceinline__ int perm32(int rho) { const int n = rho >> 4, i = rho & 15; return 8 * (i >> 2) + 4 * n + (i & 3); }

struct Unit { int pm, pn; };
struct Gemm { const bf16_t* A; const bf16_t* Bt; int M, N, K; };

struct StaticOrder {
    int nM, nN, nwg, G, c;
    __host__ __device__ void init(int M, int N, int G_, int c_) { nM = M / BM; nN = N / BM; nwg = nM * nN; G = G_; c = c_; }
    __host__ __device__ bool next(int i, Unit& u) const {
        const long L = (long)i * G + c; if (L >= nwg) return false;
        int wgid = (int)L; { const int q = nwg / NXCD, r = nwg % NXCD, xcd = wgid % NXCD, off = wgid / NXCD; wgid = (xcd < r ? xcd * (q + 1) : r * (q + 1) + (xcd - r) * q) + off; }
        const int nig = WGM * nN, gid = wgid / nig, fm = gid * WGM, gsz = (nM - fm) < WGM ? (nM - fm) : WGM;
        u.pm = fm + ((wgid % nig) % gsz); u.pn = (wgid % nig) / gsz; return true;
    }
    __device__ __forceinline__ void a_ready(const Unit&) const {}
    __device__ __forceinline__ void done(const Unit&) const {}
};
__device__ __forceinline__ unsigned cvt_pk_bf16(float lo, float hi) { unsigned r; asm volatile("v_cvt_pk_bf16_f32 %0, %1, %2" : "=v"(r) : "v"(lo), "v"(hi)); return r; }
typedef float f32x2 __attribute__((ext_vector_type(2)));
__device__ __forceinline__ f32x2 gelu_pk(f32x2 v) {
    const f32x2 av = __builtin_elementwise_abs(v), d = av * 0.2316418882f + 1.0f;
    f32x2 t; t.x = __builtin_amdgcn_rcpf(d.x); t.y = __builtin_amdgcn_rcpf(d.y);
    f32x2 q = t * 0.5307027145f + (-0.7265760135f); q = q * t + 0.7107068705f; q = q * t + (-0.142248368f); q = q * t + 0.127414796f; q = q * t;
    const f32x2 s = (v * v) * (-0.72134752044f);
    f32x2 e; e.x = __builtin_amdgcn_exp2f(s.x); e.y = __builtin_amdgcn_exp2f(s.y);
    const f32x2 m = v * (q * e), r = v - m;
    f32x2 o; o.x = v.x < 0.f ? m.x : r.x; o.y = v.y < 0.f ? m.y : r.y; return o;
}
template <class Epi, class Sched, bool ALIGN_EPI = false, bool SP2 = false>
__device__ __forceinline__ void gemm_phase(PG8_LAS unsigned char* lds, const Gemm g, const Sched& S, const Epi& E) {
    int tid_ = threadIdx.x; asm volatile("" : "+v"(tid_));
    const int tid = tid_, wid = __builtin_amdgcn_readfirstlane(tid >> 6), lane = tid & 63, wr = wid >> 2, wc = wid & 3, fr = lane & 15, fq = lane >> 4;
    const int K = g.K, nt = K / BK;
    unsigned voffA[2], voffB[2];
#pragma unroll
    for (int i = 0; i < 2; ++i) { int R, C; stage_rc(tid * 16 + i * 8192, R, C); const int Rb = Epi::PERM ? ((R & ~31) + perm32(R & 31)) : R;
        voffA[i] = (unsigned)(R * K + C) * 2u; voffB[i] = (unsigned)(Rb * K + C) * 2u; }
    const size_t kstep = (size_t)(BK * 2);
    const size_t hstep = (size_t)HALF * K * 2;
    const size_t tstep = 2 * hstep;
    const unsigned ldsw = (unsigned)wid * 1024u;
    const int aoff = lds_byte(wr * 64 + fr, fq * 8), boff = lds_byte(wc * 32 + fr, fq * 8);
#define PG8_SA(b, h) (((b) * 2 + (h)) * HTB)
#define PG8_SB(b, h) ((4 + (b) * 2 + (h)) * HTB)
#define PG8_STAGE(bufoff, gbase, voff) do { _Pragma("unroll") for (int _i = 0; _i < 2; ++_i) \
        __builtin_amdgcn_global_load_lds((const unsigned*)((const char*)(gbase) + (voff)[_i]), (PG8_LAS unsigned*)(lds + (bufoff) + ldsw + _i * 8192), 16, 0, 0); } while (0)
#define PG8_LDA(dst, b, h) do { _Pragma("unroll") for (int m = 0; m < 4; ++m) _Pragma("unroll") for (int k = 0; k < 2; ++k) dst[m][k] = *(const PG8_LAS bf16x8*)(lds + PG8_SA(b, h) + aoff + m * 2048 + k * 1024); } while (0)
#define PG8_LDB(dst, b, h) do { _Pragma("unroll") for (int n = 0; n < 2; ++n) _Pragma("unroll") for (int k = 0; k < 2; ++k) dst[n][k] = *(const PG8_LAS bf16x8*)(lds + PG8_SB(b, h) + boff + n * 2048 + k * 1024); } while (0)
#define PG8_MMA(ai, bj, At, Bt) do { __builtin_amdgcn_s_setprio(1); _Pragma("unroll") for (int m = 0; m < 4; ++m) _Pragma("unroll") for (int n = 0; n < 2; ++n) _Pragma("unroll") for (int k = 0; k < 2; ++k) \
        acc[ai][bj][m][n] = __builtin_amdgcn_mfma_f32_16x16x32_bf16(Bt[n][k], At[m][k], acc[ai][bj][m][n], 0, 0, 0); __builtin_amdgcn_s_setprio(0); } while (0)
#define PG8_WAIT_V(n) asm volatile("s_waitcnt vmcnt(" #n ")" ::: "memory")
#define PG8_WAIT_L(n) asm volatile("s_waitcnt lgkmcnt(" #n ")" ::: "memory")
#define PG8_BAR __builtin_amdgcn_s_barrier()
#define PG8_SCHED __builtin_amdgcn_sched_barrier(0)
    Unit cur, nxt; int ui = 0;
    if (!S.next(0, cur)) return;
    f32x4 acc[2][2][4][2];
#pragma unroll
    for (int a = 0; a < 2; ++a)
#pragma unroll
        for (int b = 0; b < 2; ++b)
#pragma unroll
            for (int m = 0; m < 4; ++m)
#pragma unroll
                for (int n = 0; n < 2; ++n) acc[a][b][m][n] = (f32x4){0.f, 0.f, 0.f, 0.f};
    bf16x8 At[4][2], B0[2][2], B1[2][2];
    const char* cA = (const char*)g.A + (size_t)cur.pm * tstep; const char* cB = (const char*)g.Bt + (size_t)cur.pn * tstep;
    S.a_ready(cur);
    if constexpr (SP2) {
        PG8_STAGE(PG8_SB(0, 0), cB, voffB); PG8_STAGE(PG8_SB(0, 1), cB + hstep, voffB); PG8_STAGE(PG8_SA(0, 0), cA, voffA); PG8_STAGE(PG8_SA(0, 1), cA + hstep, voffA);
        if (wr == 1) PG8_BAR;
        PG8_WAIT_V(2); PG8_BAR;
        PG8_STAGE(PG8_SB(1, 0), cB + kstep, voffB); PG8_STAGE(PG8_SA(1, 0), cA + kstep, voffA); PG8_STAGE(PG8_SB(1, 1), cB + hstep + kstep, voffB);
        PG8_WAIT_V(6); PG8_BAR;
    } else {
        PG8_STAGE(PG8_SB(0, 0), cB, voffB); PG8_STAGE(PG8_SA(0, 0), cA, voffA); PG8_STAGE(PG8_SB(0, 1), cB + hstep, voffB); PG8_STAGE(PG8_SA(0, 1), cA + hstep, voffA);
        if (wr == 1) PG8_BAR;
        PG8_WAIT_V(4); PG8_BAR;
        PG8_STAGE(PG8_SB(1, 0), cB + kstep, voffB); PG8_STAGE(PG8_SA(1, 0), cA + kstep, voffA); PG8_STAGE(PG8_SB(1, 1), cB + hstep + kstep, voffB);
        PG8_WAIT_V(6); PG8_BAR;
    }
    for (;;) {
        const bool has_next = S.next(ui + 1, nxt);
        const char* nA = has_next ? (const char*)g.A + (size_t)nxt.pm * tstep : cA; const char* nB = has_next ? (const char*)g.Bt + (size_t)nxt.pn * tstep : cB;
        for (int t = 0; t < nt; t += 2) {
            const bool last = (t == nt - 2);
            const char* a1 = cA + (size_t)(t + 1) * kstep;
            const char* a2 = last ? nA : cA + (size_t)(t + 2) * kstep; const char* b2 = last ? nB : cB + (size_t)(t + 2) * kstep;
            const char* a3 = a2 + kstep; const char* b3 = b2 + kstep;
            if (last && has_next) S.a_ready(nxt);
            if constexpr (SP2) {
            PG8_LDB(B0, 0, 0); PG8_LDB(B1, 0, 1); PG8_SCHED; PG8_LDA(At, 0, 0); PG8_STAGE(PG8_SA(1, 1), a1 + hstep, voffA);
            PG8_WAIT_V(8); PG8_WAIT_L(0); PG8_BAR; PG8_MMA(0, 0, At, B0); PG8_MMA(0, 1, At, B1); PG8_BAR; PG8_SCHED;
            PG8_LDA(At, 0, 1); PG8_STAGE(PG8_SB(0, 0), b2, voffB); PG8_STAGE(PG8_SB(0, 1), b2 + hstep, voffB); PG8_STAGE(PG8_SA(0, 0), a2, voffA);
            PG8_WAIT_V(8); PG8_WAIT_L(0); PG8_BAR; PG8_MMA(1, 0, At, B0); PG8_MMA(1, 1, At, B1); PG8_BAR; PG8_SCHED;
            PG8_LDB(B0, 1, 0); PG8_LDB(B1, 1, 1); PG8_SCHED; PG8_LDA(At, 1, 0); PG8_STAGE(PG8_SA(0, 1), a2 + hstep, voffA);
            PG8_WAIT_V(8); PG8_WAIT_L(0); PG8_BAR; PG8_MMA(0, 0, At, B0); PG8_MMA(0, 1, At, B1); PG8_BAR; PG8_SCHED;
            PG8_LDA(At, 1, 1); PG8_STAGE(PG8_SB(1, 0), b3, voffB); PG8_STAGE(PG8_SB(1, 1), b3 + hstep, voffB); PG8_STAGE(PG8_SA(1, 0), a3, voffA);
            PG8_WAIT_V(8); PG8_WAIT_L(0); PG8_BAR; PG8_MMA(1, 0, At, B0); PG8_MMA(1, 1, At, B1); PG8_BAR; PG8_SCHED;
            } else {
            PG8_LDB(B0, 0, 0); PG8_SCHED; PG8_LDA(At, 0, 0); PG8_STAGE(PG8_SA(1, 1), a1 + hstep, voffA);
            PG8_WAIT_L(8); PG8_BAR; PG8_WAIT_L(0); PG8_MMA(0, 0, At, B0); PG8_BAR; PG8_SCHED;
            PG8_LDB(B1, 0, 1); PG8_STAGE(PG8_SB(0, 0), b2, voffB);
            PG8_BAR; PG8_WAIT_L(0); PG8_MMA(0, 1, At, B1); PG8_BAR;
            PG8_LDA(At, 0, 1); PG8_STAGE(PG8_SA(0, 0), a2, voffA);
            PG8_BAR; PG8_WAIT_L(0); PG8_MMA(1, 0, At, B0); PG8_BAR; PG8_SCHED;
            PG8_STAGE(PG8_SB(0, 1), b2 + hstep, voffB);
            PG8_WAIT_V(6); PG8_BAR; PG8_MMA(1, 1, At, B1); PG8_BAR;
            PG8_LDB(B0, 1, 0); PG8_SCHED; PG8_LDA(At, 1, 0); PG8_STAGE(PG8_SA(0, 1), a2 + hstep, voffA);
            PG8_WAIT_L(8); PG8_BAR; PG8_WAIT_L(0); PG8_MMA(0, 0, At, B0); PG8_BAR; PG8_SCHED;
            PG8_LDB(B1, 1, 1); PG8_STAGE(PG8_SB(1, 0), b3, voffB);
            PG8_BAR; PG8_WAIT_L(0); PG8_MMA(0, 1, At, B1); PG8_BAR;
            PG8_LDA(At, 1, 1); PG8_STAGE(PG8_SA(1, 0), a3, voffA);
            PG8_BAR; PG8_WAIT_L(0); PG8_MMA(1, 0, At, B0); PG8_BAR; PG8_SCHED;
            PG8_STAGE(PG8_SB(1, 1), b3 + hstep, voffB);
            PG8_WAIT_V(6); PG8_BAR; PG8_MMA(1, 1, At, B1); PG8_BAR;
            }
        }
        if constexpr (ALIGN_EPI) { if (wr == 0) PG8_BAR; }
        if constexpr (!Epi::AFTER_DRAIN) { E(acc, cur, wr, wc, fr, fq); S.done(cur); }
        if (!has_next) break;
#pragma unroll
        for (int a = 0; a < 2; ++a)
#pragma unroll
            for (int b = 0; b < 2; ++b)
#pragma unroll
                for (int m = 0; m < 4; ++m)
#pragma unroll
                    for (int n = 0; n < 2; ++n) acc[a][b][m][n] = (f32x4){0.f, 0.f, 0.f, 0.f};
        cur = nxt; cA = nA; cB = nB; ++ui;
        if constexpr (ALIGN_EPI) { if (wr == 1) PG8_BAR; }
    }
    PG8_WAIT_V(0);
    if constexpr (!ALIGN_EPI) { if (wr == 0) PG8_BAR; }
    PG8_BAR;
    if constexpr (Epi::AFTER_DRAIN) { E.fused(acc, cur, wr, wc, fr, fq, lds, wid, lane); S.done(cur); }
#undef PG8_SA
#undef PG8_SB
#undef PG8_STAGE
#undef PG8_LDA
#undef PG8_LDB
#undef PG8_MMA
#undef PG8_WAIT_V
#undef PG8_WAIT_L
#undef PG8_BAR
#undef PG8_SCHED
}
}
#define GAS __attribute__((address_space(1)))
#define LAS __attribute__((address_space(3)))
typedef unsigned short bf16;
typedef unsigned v4u __attribute__((ext_vector_type(4)));
typedef float f32x4 __attribute__((ext_vector_type(4)));
typedef short bf16x8 __attribute__((ext_vector_type(8)));
typedef GAS unsigned gu32;
typedef GAS unsigned long long gu64;
#define RLX_AGENT __ATOMIC_RELAXED, __HIP_MEMORY_SCOPE_AGENT
#define LDS_WAIT() asm volatile("s_waitcnt lgkmcnt(0)" ::: "memory")
#define VM_WAIT() asm volatile("s_waitcnt vmcnt(0)" ::: "memory")
__device__ __forceinline__ unsigned long long rt() { return __builtin_amdgcn_s_memrealtime(); }
__device__ __forceinline__ unsigned f2bf(float f) { unsigned u = __builtin_bit_cast(unsigned, f); return (u + 0x7fffu + ((u >> 16) & 1u)) >> 16; }
__device__ __forceinline__ unsigned pk2(float lo, float hi) { return f2bf(lo) | (f2bf(hi) << 16); }
#define XB_TMO      128
#define XB_XCNT(j)  (256  + 64 * (j))
#define XB_XSUB(j)  (1280 + 64 * (j))
#define XB_XGEN(j)  (2304 + 64 * (j))
#define XB_TOP      3328
#define XB_TOPGEN   3392
#define XCD_BAR_WORDS 3456
#define XB_SPIN_CAP (1u << 18)

__device__ __forceinline__ unsigned xb_ld(unsigned* p)              { return __hip_atomic_load(p, __ATOMIC_RELAXED, __HIP_MEMORY_SCOPE_AGENT); }
__device__ __forceinline__ unsigned xb_add(unsigned* p, unsigned v) { return __hip_atomic_fetch_add(p, v, __ATOMIC_RELAXED, __HIP_MEMORY_SCOPE_AGENT); }
__device__ __forceinline__ unsigned xb_xcc_id() { return (unsigned)__builtin_amdgcn_s_getreg((3 << 11) | 20) & 0xFu; }
#define XB_SPIN(cond, bar) do { unsigned _sp = 0; while (cond) { __builtin_amdgcn_s_sleep(1); \
    if ((++_sp & 255u) == 0u) { if (xb_ld(&(bar)[XB_TMO])) break; if (_sp > XB_SPIN_CAP) { atomicAdd(&(bar)[XB_TMO], 1u); break; } } } } while (0)

struct XcdBarrier {
    unsigned* bar; unsigned x;
    volatile LAS unsigned* st;
};

__device__ __forceinline__ XcdBarrier xcd_barrier_post(unsigned* bar, volatile LAS unsigned* st) {
    XcdBarrier b; b.bar = bar; b.x = xb_xcc_id(); b.st = st;
    if (threadIdx.x == 0) (void)xb_add(&bar[XB_XCNT(b.x)], 1u);
    return b;
}
__device__ __forceinline__ void xcd_barrier_complete(unsigned* bar, unsigned x, unsigned& nloc, unsigned& nx) {
    const unsigned G = gridDim.x * gridDim.y * gridDim.z;
    unsigned sum, cnt, mine, sp = 0u;
    for (;;) {
        sum = 0u; cnt = 0u; mine = 0u;
#pragma unroll
        for (unsigned j = 0; j < 16; ++j) { const unsigned c = xb_ld(&bar[XB_XCNT(j)]); sum += c; cnt += (c > 0u) ? 1u : 0u; mine = (j == x) ? c : mine; }
        if (sum == G) break;
        __builtin_amdgcn_s_sleep(1);
        if ((++sp & 255u) == 0u) { if (xb_ld(&bar[XB_TMO])) break; if (sp > XB_SPIN_CAP) { atomicAdd(&bar[XB_TMO], 1u); break; } }
    }
    nloc = mine > 0u ? mine : 1u; nx = cnt > 0u ? cnt : 1u;
}

__device__ __forceinline__ void xcd_barrier(const XcdBarrier& b) {
    asm volatile("s_waitcnt vmcnt(0)" ::: "memory");
    __syncthreads();
    if (threadIdx.x == 0) {
        unsigned* bar = b.bar;
        __builtin_amdgcn_s_waitcnt(0);
        unsigned nloc = b.st[0], nx = b.st[1];
        if (nloc == 0u) { xcd_barrier_complete(bar, b.x, nloc, nx); b.st[0] = nloc; b.st[1] = nx; }
        const unsigned old = xb_add(&bar[XB_XSUB(b.x)], 1u);
        const unsigned gen = old / nloc;
        if (old + 1u == (gen + 1u) * nloc) {
            __builtin_amdgcn_fence(__ATOMIC_RELEASE, "agent");
            asm volatile("s_waitcnt vmcnt(0)" ::: "memory");
            const unsigned og = xb_add(&bar[XB_TOP], 1u);
            const unsigned tg = og / nx;
            if (og + 1u == (tg + 1u) * nx) xb_add(&bar[XB_TOPGEN], 1u);
            else XB_SPIN(xb_ld(&bar[XB_TOPGEN]) == tg, bar);
            __builtin_amdgcn_fence(__ATOMIC_ACQUIRE, "agent");
            xb_add(&bar[XB_XGEN(b.x)], 1u);
            asm volatile("s_waitcnt vmcnt(0)" ::: "memory");
        } else {
            XB_SPIN(xb_ld(&bar[XB_XGEN(b.x)]) == gen, bar);
            __builtin_amdgcn_fence(__ATOMIC_ACQUIRE, "agent");
            asm volatile("s_waitcnt vmcnt(0)" ::: "memory");
        }
    }
    __syncthreads();
}

constexpr int NWAVES = 8, NTHREADS = NWAVES * 64;
constexpr int BATCH = 16, SEQ = 2048, D = 2048, M = BATCH * SEQ, DEPTH = 4;
constexpr int DFF = 5632, NFFIN = 2 * DFF, NMIX = 14336, NMEM = 256, MMEM = BATCH * NMEM;
constexpr float EPS = 1e-6f;
constexpr float LOG2E = 1.4426950408889634f;
constexpr float QSCALE_DIFF = 0.125f * LOG2E;
constexpr float QSCALE_MEM = 0.08838834764831845f * LOG2E;

constexpr size_t MiB = (size_t)1 << 20;
constexpr size_t WS_CTL = 0;
constexpr size_t ZERO_BYTES = 1 * MiB;
constexpr size_t WS_W = 8 * MiB;
constexpr size_t W_F1IN = 0, W_F1OUT = 44 * MiB, W_F2IN = 66 * MiB, W_F2OUT = 110 * MiB, W_MIXIN = 132 * MiB, W_BR3 = 188 * MiB, W_MO = 200 * MiB, W_XQ = 208 * MiB, W_XO = 210 * MiB, W_BYTES = 212 * MiB;
static_assert((size_t)NFFIN * D * 2 == 44 * MiB && (size_t)D * DFF * 2 == 22 * MiB && (size_t)NMIX * D * 2 == 56 * MiB, "weight sizes");
constexpr size_t WS_WXKV = WS_W + W_BYTES;
constexpr size_t WS_H = WS_WXKV + 16 * MiB;
constexpr size_t WS_HB = WS_H + 256 * MiB;
constexpr size_t WS_MEMB = WS_HB + 128 * MiB;
constexpr size_t WS_KVX = WS_MEMB + 16 * MiB;
constexpr size_t WS_QX = WS_KVX + 32 * MiB;
constexpr size_t WS_ACT = WS_QX + 32 * MiB;
constexpr size_t WS_HID = WS_ACT;
constexpr size_t WS_QUC = WS_ACT;
constexpr size_t WS_KV2 = WS_ACT + 192 * MiB;
constexpr size_t WS_GVZ = WS_ACT + 320 * MiB;
constexpr size_t WS_GATES = WS_ACT + 448 * MiB;
constexpr size_t WS_SCR = WS_ACT + 832 * MiB;
constexpr size_t WS_RP = WS_ACT + 1088 * MiB;
constexpr size_t WS_RPGV = WS_RP + 68 * MiB;
constexpr size_t WS_RPMEM = WS_RPGV + 8 * MiB;
constexpr size_t WS_END = WS_RPMEM + 1 * MiB;
static_assert((size_t)M * DFF * 2 <= 1088 * MiB, "hid fits");

constexpr int RING_OFF = 0, RING_BYTES = 131072;
constexpr int LDSCTL_OFF = RING_BYTES, MISC_OFF = LDSCTL_OFF + 320;
constexpr int LDS_BYTES = 147456;
constexpr int RSTAB_OFF = LDSCTL_OFF + 1024;

typedef float f32x16 __attribute__((ext_vector_type(16)));
typedef unsigned u32x2 __attribute__((ext_vector_type(2)));
typedef short v4i16_t __attribute__((ext_vector_type(4)));
typedef float f32x2_t __attribute__((ext_vector_type(2)));
typedef __bf16 bf16x2_t __attribute__((ext_vector_type(2)));

__device__ __forceinline__ int opaque_tid() { int t = threadIdx.x; asm volatile("" : "+v"(t)); return t; }
#define WG_BAR() do { asm volatile("s_waitcnt lgkmcnt(0)" ::: "memory"); __builtin_amdgcn_s_barrier(); asm volatile("" ::: "memory"); } while (0)

__device__ __forceinline__ unsigned cvtpk(float lo, float hi) { f32x2_t v = {lo, hi}; bf16x2_t b = __builtin_convertvector(v, bf16x2_t); return __builtin_bit_cast(unsigned, b); }
__device__ __forceinline__ float bflo(unsigned w) { return __uint_as_float(w << 16); }
__device__ __forceinline__ float bfhi(unsigned w) { return __uint_as_float(w & 0xffff0000u); }
__device__ __forceinline__ float ex2(float x) { return __builtin_amdgcn_exp2f(x); }
__device__ __forceinline__ float rcpf_(float x) { return __builtin_amdgcn_rcpf(x); }
__device__ __forceinline__ float rsqf_(float x) { return __builtin_amdgcn_rsqf(x); }
__device__ __forceinline__ float sigmoid_(float x) { return rcpf_(1.0f + ex2(-LOG2E * x)); }
__device__ __forceinline__ float wave_sum(float v) {
#pragma unroll
    for (int o = 1; o < 64; o <<= 1) v += __shfl_xor(v, o);
    return v;
}

namespace ep {
using pg8::f32x4; using pg8::Unit; using pg8::BM; using pg8::HALF; using pg8::bf16_t; using pg8::u32x4; using pg8::f32x2; using pg8::gelu_pk;

__device__ __forceinline__ void load_rs(float (&rs)[2][4], const float* rp, LAS float* tab, int pm, int wr, int wc, int fr, int fq) {
    const int tid = (wr * 4 + wc) * 64 + fq * 16 + fr, row = tid >> 1, half = tid & 1;
    const f32x4* p = (const f32x4*)(rp + ((size_t)(pm * BM + row)) * 32 + half * 16);
    const f32x4 a = p[0], b = p[1], c = p[2], d = p[3];
    float s = (((a[0] + a[1]) + (a[2] + a[3])) + ((b[0] + b[1]) + (b[2] + b[3]))) + (((c[0] + c[1]) + (c[2] + c[3])) + ((d[0] + d[1]) + (d[2] + d[3])));
    s += __shfl_xor(s, 1);
    if (half == 0) tab[row] = rsqf_(s * (1.0f / D) + EPS);
    WG_BAR();
#pragma unroll
    for (int ai = 0; ai < 2; ++ai)
#pragma unroll
        for (int m = 0; m < 4; ++m) rs[ai][m] = tab[ai * HALF + wr * 64 + m * 16 + fr];
}
__device__ __forceinline__ f32x4 gelu4(f32x4 v) { const f32x2 a = gelu_pk((f32x2){v[0], v[1]}), b = gelu_pk((f32x2){v[2], v[3]}); return (f32x4){a.x, a.y, b.x, b.y}; }
__device__ __forceinline__ f32x4 sigm4(f32x4 v) { return (f32x4){sigmoid_(v[0]), sigmoid_(v[1]), sigmoid_(v[2]), sigmoid_(v[3])}; }
__device__ __forceinline__ u32x4 pack8(f32x4 a, f32x4 b) { u32x4 w; w.x = cvtpk(a[0], a[1]); w.y = cvtpk(a[2], a[3]); w.z = cvtpk(b[0], b[1]); w.w = cvtpk(b[2], b[3]); return w; }

template <int ACT, bool SS>
__device__ __forceinline__ void store_act(const f32x4 (&acc)[2][2][4][2], const float (&rs)[2][4], float scale, bf16_t* O, int ldc, int row0, int col0, float* ssq, int sslot, int fq) {
#pragma unroll
    for (int ai = 0; ai < 2; ++ai)
#pragma unroll
        for (int m = 0; m < 4; ++m) {
            const int r = row0 + ai * HALF + m * 16; bf16_t* rowp = O + (size_t)r * ldc + col0; const float s = rs[ai][m] * scale; float ss = 0.f;
#pragma unroll
            for (int bj = 0; bj < 2; ++bj) {
                f32x4 v0 = acc[ai][bj][m][0] * s, v1 = acc[ai][bj][m][1] * s;
                if (ACT == 1) { v0 = gelu4(v0); v1 = gelu4(v1); }
                if (ACT == 2) { v0 = sigm4(v0); v1 = sigm4(v1); }
                if (SS) { ss += (v0[0] * v0[0] + v0[1] * v0[1]) + (v0[2] * v0[2] + v0[3] * v0[3]); ss += (v1[0] * v1[0] + v1[1] * v1[1]) + (v1[2] * v1[2] + v1[3] * v1[3]); }
                *(u32x4*)(rowp + bj * HALF) = pack8(v0, v1);
            }
            if (SS) { ss += __shfl_xor(ss, 16); ss += __shfl_xor(ss, 32); if (fq == 0) ssq[(size_t)r * 16 + sslot] = ss; }
        }
}
template <int ACT>
__device__ __forceinline__ void store_pair(const f32x4 (&acc)[2][2][4][2], const float (&rs)[2][4], bf16_t* O, int ldc, int row0, int col0) {
#pragma unroll
    for (int ai = 0; ai < 2; ++ai)
#pragma unroll
        for (int m = 0; m < 4; ++m) {
            const int r = row0 + ai * HALF + m * 16; bf16_t* rowp = O + (size_t)r * ldc + col0; const float s = rs[ai][m];
            f32x4 o[2];
#pragma unroll
            for (int n = 0; n < 2; ++n) {
                f32x4 a = acc[ai][0][m][n] * s; const f32x4 b = acc[ai][1][m][n] * s;
                if (ACT == 1) a = a * sigm4(a);
                o[n] = a * b;
            }
            *(u32x4*)rowp = pack8(o[0], o[1]);
        }
}

struct EpiFfnIn {
    static constexpr bool PERM = true, AFTER_DRAIN = false;
    const float* rp; LAS float* tab; bf16_t* hid;
    __device__ __forceinline__ void operator()(const f32x4 (&acc)[2][2][4][2], const Unit& u, int wr, int wc, int fr, int fq) const {
        const int row0 = u.pm * BM + wr * 64 + fr; float rs[2][4]; load_rs(rs, rp, tab, u.pm, wr, wc, fr, fq);
        store_pair<1>(acc, rs, hid, DFF, row0, u.pn * 128 + wc * 32 + 8 * fq);
    }
};
struct EpiScale {
    static constexpr bool PERM = true, AFTER_DRAIN = false;
    const float* rp; LAS float* tab; bf16_t* O; int ldc; float scale;
    __device__ __forceinline__ void operator()(const f32x4 (&acc)[2][2][4][2], const Unit& u, int wr, int wc, int fr, int fq) const {
        const int row0 = u.pm * BM + wr * 64 + fr; float rs[2][4]; load_rs(rs, rp, tab, u.pm, wr, wc, fr, fq);
        store_act<0, false>(acc, rs, scale, O, ldc, row0, u.pn * BM + wc * 32 + 8 * fq, nullptr, 0, fq);
    }
};
struct EpiMixIn {
    static constexpr bool PERM = true, AFTER_DRAIN = false;
    const float* rp; LAS float* tab; float* rpgv; bf16_t *quc, *kv2, *gvz, *gates;
    __device__ __forceinline__ void operator()(const f32x4 (&acc)[2][2][4][2], const Unit& u, int wr, int wc, int fr, int fq) const {
        const int row0 = u.pm * BM + wr * 64 + fr; float rs[2][4]; load_rs(rs, rp, tab, u.pm, wr, wc, fr, fq);
        const int pn = u.pn, cw = wc * 32 + 8 * fq; const size_t PL = (size_t)M * 1024;
        if (pn < 4)        store_act<0, false>(acc, rs, QSCALE_DIFF, quc, 1024, row0, pn * 256 + cw, nullptr, 0, fq);
        else if (pn < 8)   store_act<0, false>(acc, rs, 1.0f, kv2, 1024, row0, (pn - 4) * 256 + cw, nullptr, 0, fq);
        else if (pn < 12)  store_act<0, false>(acc, rs, 1.0f, kv2 + PL, 1024, row0, (pn - 8) * 256 + cw, nullptr, 0, fq);
        else if (pn < 16)  store_act<1, false>(acc, rs, 1.0f, quc + PL, 1024, row0, (pn - 12) * 256 + cw, nullptr, 0, fq);
        else if (pn < 20)  store_act<1, true>(acc, rs, 1.0f, gvz, 1024, row0, (pn - 16) * 256 + cw, rpgv, (pn - 16) * 4 + wc, fq);
        else if (pn < 24)  store_act<0, false>(acc, rs, 1.0f, quc + 2 * PL, 1024, row0, (pn - 20) * 256 + cw, nullptr, 0, fq);
        else if (pn < 32)  store_pair<0>(acc, rs, gvz + PL, 1024, row0, (pn - 24) * 128 + cw);
        else               store_act<2, false>(acc, rs, 1.0f, gates, 6144, row0, (pn - 32) * 256 + cw, nullptr, 0, fq);
    }
};
struct EpiResid {
    static constexpr bool PERM = false, AFTER_DRAIN = false;
    const float* hin; float* hout; bf16_t* hb; float* rp_next; float alpha;
    __device__ __forceinline__ void operator()(const f32x4 (&acc)[2][2][4][2], const Unit& u, int wr, int wc, int fr, int fq) const {
        const int row0 = u.pm * BM + wr * 64 + fr, col0 = u.pn * BM + wc * 32 + 4 * fq;
#pragma unroll
        for (int ai = 0; ai < 2; ++ai)
#pragma unroll
            for (int m = 0; m < 4; ++m) {
                const int r = row0 + ai * HALF + m * 16; const size_t off = (size_t)r * D + col0; float ss = 0.f;
#pragma unroll
                for (int bj = 0; bj < 2; ++bj)
#pragma unroll
                    for (int n = 0; n < 2; ++n) {
                        const size_t c = off + bj * HALF + n * 16;
                        const f32x4 o = *(const f32x4*)(hin + c) + acc[ai][bj][m][n] * alpha;
                        *(f32x4*)(hout + c) = o;
                        u32x2 w; w.x = cvtpk(o[0], o[1]); w.y = cvtpk(o[2], o[3]); *(u32x2*)(hb + c) = w;
                        ss += (o[0] * o[0] + o[1] * o[1]) + (o[2] * o[2] + o[3] * o[3]);
                    }
                ss += __shfl_xor(ss, 16); ss += __shfl_xor(ss, 32);
                if (fq == 0) rp_next[(size_t)r * 32 + u.pn * 4 + wc] = ss;
                asm volatile("" ::: "memory");
            }
    }
};
struct EpiMerge {
    static constexpr bool PERM = false, AFTER_DRAIN = false;
    const bf16_t* gates; float* scr; bf16_t* merged;
    __device__ __forceinline__ void operator()(const f32x4 (&acc)[2][2][4][2], const Unit& u, int wr, int wc, int fr, int fq) const {
        const int br = u.pm >> 7, pm = u.pm & 127, pn = u.pn & 7;
        const int row0 = pm * BM + wr * 64 + fr, col0 = pn * BM + wc * 32 + 4 * fq;
#pragma unroll
        for (int ai = 0; ai < 2; ++ai)
#pragma unroll
            for (int m = 0; m < 4; ++m) {
                const int r = row0 + ai * HALF + m * 16;
#pragma unroll
                for (int bj = 0; bj < 2; ++bj)
#pragma unroll
                    for (int n = 0; n < 2; ++n) {
                        const int c = col0 + bj * HALF + n * 16;
                        const u32x2 gw = *(const u32x2*)(gates + (size_t)r * 6144 + br * 2048 + c);
                        const f32x4 g = (f32x4){bflo(gw.x), bfhi(gw.x), bflo(gw.y), bfhi(gw.y)};
                        f32x4 v = acc[ai][bj][m][n] * g; float* sp = scr + (size_t)r * D + c;
                        if (br == 0) *(f32x4*)sp = v;
                        else { v = v + *(const f32x4*)sp;
                            if (br == 1) *(f32x4*)sp = v;
                            else { u32x2 w; w.x = cvtpk(v[0], v[1]); w.y = cvtpk(v[2], v[3]); *(u32x2*)(merged + (size_t)r * D + c) = w; } }
                    }
                asm volatile("" ::: "memory");
            }
    }
};
struct TripleOrder {
    pg8::StaticOrder base;
    __device__ __forceinline__ bool next(int i, Unit& u) const { Unit b; const int q = i / 3, br = i - 3 * q; if (!base.next(q, b)) return false; u.pm = b.pm + 128 * br; u.pn = b.pn + 8 * br; return true; }
    __device__ __forceinline__ void a_ready(const Unit&) const {}
    __device__ __forceinline__ void done(const Unit&) const {}
};
}

template <int DQK, bool CAUSAL>
__device__ __forceinline__ void attn_pass(f32x16 (&o)[4], const bf16* qrow, const bf16* kbase, size_t ldk, const bf16* vbase, size_t ldv,
                                          int ntiles, int qpos, int wq_min, int wq_max, float slope2, LAS unsigned char* lds) {
    constexpr int PK = (DQK + 8) * 2, KBYTES = 64 * PK, NKS = DQK / 16, KCH = DQK / 64, CPK = DQK / 8;
    LAS unsigned char* Ks = lds; LAS unsigned char* Vs = lds + ((KBYTES + 1023) & ~1023);
    const int tid = opaque_tid(), lane = tid & 63, r = lane & 31, h = lane >> 5;
    bf16x8 qr[NKS];
#pragma unroll
    for (int ks = 0; ks < NKS; ++ks) qr[ks] = *(const bf16x8*)(qrow + 16 * ks + 8 * h);
    v4u kreg[KCH], vreg[2];
#define ATT_GLOAD(t) do { \
        _Pragma("unroll") for (int i_ = 0; i_ < KCH; ++i_) { const int c_ = tid + 512 * i_, key_ = c_ / CPK, ch_ = c_ % CPK; kreg[i_] = *(const v4u*)(kbase + (size_t)(64 * (t) + key_) * ldk + ch_ * 8); } \
        _Pragma("unroll") for (int i_ = 0; i_ < 2; ++i_) { const int c_ = tid + 512 * i_, key_ = c_ >> 4, c16_ = c_ & 15; vreg[i_] = *(const v4u*)(vbase + (size_t)(64 * (t) + key_) * ldv + c16_ * 8); } } while (0)
#define ATT_LWRITE() do { \
        _Pragma("unroll") for (int i_ = 0; i_ < KCH; ++i_) { const int c_ = tid + 512 * i_, key_ = c_ / CPK, ch_ = c_ % CPK; *(LAS v4u*)(Ks + key_ * PK + ch_ * 16) = kreg[i_]; } \
        _Pragma("unroll") for (int i_ = 0; i_ < 2; ++i_) { const int c_ = tid + 512 * i_, key_ = c_ >> 4, c16_ = c_ & 15; *(LAS v4u*)(Vs + (c16_ >> 2) * 4096 + (key_ >> 4) * 1024 + (key_ & 15) * 64 + (c16_ & 3) * 16) = vreg[i_]; } } while (0)
    const int vb = ((lane >> 4) & 1) * 32 + (lane & 3) * 8 + (4 * h + ((lane & 15) >> 2)) * 64;
    float m_run = -1e30f, l_run = 0.f;
#pragma unroll
    for (int dt = 0; dt < 4; ++dt)
#pragma unroll
        for (int e = 0; e < 16; ++e) o[dt][e] = 0.f;
    ATT_GLOAD(0);
    for (int t = 0; t < ntiles; ++t) {
        ATT_LWRITE();
        WG_BAR();
        if (t + 1 < ntiles) ATT_GLOAD(t + 1);
        const bool active = !CAUSAL || (64 * t <= wq_max);
        if (active) {
            f32x16 s0, s1;
            if (CAUSAL) { const float b0 = slope2 * (float)(64 * t + 4 * h - qpos);
#pragma unroll
                for (int e = 0; e < 16; ++e) { const int cr = (e & 3) + 8 * (e >> 2); s0[e] = fmaf(slope2, (float)cr, b0); s1[e] = fmaf(slope2, (float)(32 + cr), b0); } }
            else {
#pragma unroll
                for (int e = 0; e < 16; ++e) { s0[e] = 0.f; s1[e] = 0.f; } }
#pragma unroll
            for (int ks = 0; ks < NKS; ++ks) {
                const bf16x8 k0 = *(const LAS bf16x8*)(Ks + r * PK + (16 * ks + 8 * h) * 2);
                const bf16x8 k1 = *(const LAS bf16x8*)(Ks + (32 + r) * PK + (16 * ks + 8 * h) * 2);
                s0 = __builtin_amdgcn_mfma_f32_32x32x16_bf16(k0, qr[ks], s0, 0, 0, 0);
                s1 = __builtin_amdgcn_mfma_f32_32x32x16_bf16(k1, qr[ks], s1, 0, 0, 0);
            }
            if (CAUSAL && (64 * t + 63 > wq_min)) { const int kb = 64 * t + 4 * h - qpos;
#pragma unroll
                for (int e = 0; e < 16; ++e) { const int cr = (e & 3) + 8 * (e >> 2); if (kb + cr > 0) s0[e] = -INFINITY; if (kb + 32 + cr > 0) s1[e] = -INFINITY; } }
            float mx = fmaxf(s0[0], s1[0]);
#pragma unroll
            for (int e = 1; e < 16; ++e) mx = fmaxf(mx, fmaxf(s0[e], s1[e]));
            mx = fmaxf(mx, __shfl_xor(mx, 32));
            const float mnew = fmaxf(m_run, mx), alpha = ex2(m_run - mnew); m_run = mnew;
            float ps = 0.f;
#pragma unroll
            for (int e = 0; e < 16; ++e) { s0[e] = ex2(s0[e] - mnew); s1[e] = ex2(s1[e] - mnew); ps += s0[e] + s1[e]; }
            l_run = l_run * alpha + ps;
#pragma unroll
            for (int dt = 0; dt < 4; ++dt)
#pragma unroll
                for (int e = 0; e < 16; ++e) o[dt][e] *= alpha;
            v4u pw[4];
            pw[0] = (v4u){cvtpk(s0[0], s0[1]), cvtpk(s0[2], s0[3]), cvtpk(s0[4], s0[5]), cvtpk(s0[6], s0[7])};
            pw[1] = (v4u){cvtpk(s0[8], s0[9]), cvtpk(s0[10], s0[11]), cvtpk(s0[12], s0[13]), cvtpk(s0[14], s0[15])};
            pw[2] = (v4u){cvtpk(s1[0], s1[1]), cvtpk(s1[2], s1[3]), cvtpk(s1[4], s1[5]), cvtpk(s1[6], s1[7])};
            pw[3] = (v4u){cvtpk(s1[8], s1[9]), cvtpk(s1[10], s1[11]), cvtpk(s1[12], s1[13]), cvtpk(s1[14], s1[15])};
#pragma unroll
            for (int s = 0; s < 4; ++s) {
                const bf16x8 pf = __builtin_bit_cast(bf16x8, pw[s]);
#pragma unroll
                for (int dt = 0; dt < 4; ++dt) {
                    const v4i16_t lo = __builtin_amdgcn_ds_read_tr16_b64_v4i16((LAS v4i16_t*)(Vs + vb + dt * 4096 + s * 1024));
                    const v4i16_t hi = __builtin_amdgcn_ds_read_tr16_b64_v4i16((LAS v4i16_t*)(Vs + vb + dt * 4096 + s * 1024 + 512));
                    const bf16x8 vf = (bf16x8){lo[0], lo[1], lo[2], lo[3], hi[0], hi[1], hi[2], hi[3]};
                    o[dt] = __builtin_amdgcn_mfma_f32_32x32x16_bf16(vf, pf, o[dt], 0, 0, 0);
                }
            }
        }
        WG_BAR();
    }
#undef ATT_GLOAD
#undef ATT_LWRITE
    const float lt = l_run + __shfl_xor(l_run, 32), inv = 1.0f / lt;
#pragma unroll
    for (int dt = 0; dt < 4; ++dt)
#pragma unroll
        for (int e = 0; e < 16; ++e) o[dt][e] *= inv;
}

__device__ __forceinline__ void diff_attn_unit(int b, int hh, int qb, bf16* q  , const bf16* k, const bf16* v, const float* subln  , float lam, float one_m_lam_init, LAS unsigned char* lds) {
    const int tid = opaque_tid(), lane = tid & 63, r = lane & 31, h = lane >> 5, w = __builtin_amdgcn_readfirstlane(tid >> 6);
    const size_t rowbase = (size_t)b * SEQ; const int q0 = qb * 256, qpos = q0 + 32 * w + r;
    const float slope2 = ex2(-(float)(hh + 1)) * LOG2E;
    bf16* qrow = q + (rowbase + qpos) * 1024 + hh * 128;
    const bf16* kb_ = k + rowbase * 1024 + hh * 128; const bf16* vb_ = v + rowbase * 1024 + hh * 128;
    f32x16 o1[4], o2[4];
    attn_pass<64, true>(o1, qrow, kb_, 1024, vb_, 1024, 4 * (qb + 1), qpos, q0 + 32 * w, q0 + 32 * w + 31, slope2, lds);
    attn_pass<64, true>(o2, qrow + 64, kb_ + 64, 1024, vb_, 1024, 4 * (qb + 1), qpos, q0 + 32 * w, q0 + 32 * w + 31, slope2, lds);
    float ss = 0.f;
#pragma unroll
    for (int dt = 0; dt < 4; ++dt)
#pragma unroll
        for (int e = 0; e < 16; ++e) { const float d = o1[dt][e] - lam * o2[dt][e]; o1[dt][e] = d; ss += d * d; }
    ss += __shfl_xor(ss, 32);
    const float sc = rsqf_(ss * (1.0f / 128.0f) + EPS) * one_m_lam_init;
#pragma unroll
    for (int dt = 0; dt < 4; ++dt)
#pragma unroll
        for (int g = 0; g < 4; ++g) {
            const int dv = 32 * dt + 8 * g + 4 * h; const f32x4 gn = *(const f32x4*)(subln + dv);
            u32x2 wv; wv.x = cvtpk(o1[dt][4 * g] * sc * gn[0], o1[dt][4 * g + 1] * sc * gn[1]); wv.y = cvtpk(o1[dt][4 * g + 2] * sc * gn[2], o1[dt][4 * g + 3] * sc * gn[3]);
            *(u32x2*)(qrow + dv) = wv;
        }
}
__device__ __forceinline__ void mem_attn_unit(int b, int hh, int qb, bf16* qx, const bf16* kvx  , LAS unsigned char* lds) {
    const int tid = opaque_tid(), lane = tid & 63, r = lane & 31, h = lane >> 5, w = __builtin_amdgcn_readfirstlane(tid >> 6);
    const size_t row = (size_t)b * SEQ + qb * 256 + 32 * w + r;
    bf16* qrow = qx + row * 512 + hh * 128;
    const bf16* kb_ = kvx + (size_t)b * NMEM * 4096 + hh * 128; const bf16* vb_ = kb_ + 512;
    f32x16 o[4];
    attn_pass<128, false>(o, qrow, kb_, 4096, vb_, 4096, NMEM / 64, 0, 0, 0, 0.f, lds);
#pragma unroll
    for (int dt = 0; dt < 4; ++dt)
#pragma unroll
        for (int g = 0; g < 4; ++g) {
            const int dv = 32 * dt + 8 * g + 4 * h;
            u32x2 wv; wv.x = cvtpk(o[dt][4 * g], o[dt][4 * g + 1]); wv.y = cvtpk(o[dt][4 * g + 2], o[dt][4 * g + 3]);
            *(u32x2*)(qrow + dv) = wv;
        }
}

__device__ __forceinline__ void sgu_unit(int b, int ck, int g, bf16* u  , const bf16* gv  , const float* rpgv  , const float* ws  , const float* sb  , const float* snorm  , LAS unsigned char* lds) {
    const int tid = opaque_tid(), lane = tid & 63, r = lane & 31, h = lane >> 5, w = __builtin_amdgcn_readfirstlane(tid >> 6);
    const size_t t0 = (size_t)b * SEQ + ck * 128; const int c0 = g * 128;
    LAS unsigned char* Gs = lds; LAS float* rstd = (LAS float*)(lds + 32768);
#pragma unroll
    for (int i = 0; i < 4; ++i) { const int c = tid + 512 * i, s = c >> 4, c16 = c & 15;
        const v4u val = *(const v4u*)(gv + (t0 + s) * 1024 + c0 + c16 * 8);
        *(LAS v4u*)(Gs + (c16 >> 2) * 8192 + (s >> 4) * 1024 + (s & 15) * 64 + (c16 & 3) * 16) = val; }
    if (tid < 128) { const f32x4* pp = (const f32x4*)(rpgv + (t0 + tid) * 16); const f32x4 a = pp[0], b_ = pp[1], c = pp[2], d = pp[3];
        const float sq = (((a[0] + a[1]) + (a[2] + a[3])) + ((b_[0] + b_[1]) + (b_[2] + b_[3]))) + (((c[0] + c[1]) + (c[2] + c[3])) + ((d[0] + d[1]) + (d[2] + d[3])));
        rstd[tid] = rsqf_(sq * (1.0f / 1024.0f) + EPS); }
    WG_BAR();
    const int db = w & 3, th = w >> 2;
    f32x16 acc[2];
#pragma unroll
    for (int i = 0; i < 2; ++i)
#pragma unroll
        for (int e = 0; e < 16; ++e) acc[i][e] = 0.f;
    const int ab = db * 8192 + (8 * h + ((lane & 15) >> 2)) * 64 + (16 * ((lane >> 4) & 1) + 4 * (lane & 3)) * 2;
    const int nks = 4 * th + 4;
    for (int ks = 0; ks < nks; ++ks) {
        const v4i16_t lo = __builtin_amdgcn_ds_read_tr16_b64_v4i16((LAS v4i16_t*)(Gs + ab + ks * 1024));
        const v4i16_t hi = __builtin_amdgcn_ds_read_tr16_b64_v4i16((LAS v4i16_t*)(Gs + ab + ks * 1024 + 256));
        const bf16x8 af = (bf16x8){lo[0], lo[1], lo[2], lo[3], hi[0], hi[1], hi[2], hi[3]};
        const int s0 = 16 * ks + 8 * h;
        const f32x4 r0 = *(const LAS f32x4*)(rstd + s0), r1 = *(const LAS f32x4*)(rstd + s0 + 4);
#pragma unroll
        for (int i = 0; i < 2; ++i) {
            const int tb = 2 * th + i;
            if (ks < 2 * (tb + 1)) {
                const int t = 32 * tb + r; const float* wp = ws + ((size_t)(g * 128 + t)) * 128 + s0;
                f32x4 w0 = *(const f32x4*)wp, w1 = *(const f32x4*)(wp + 4);
                w0 = w0 * r0; w1 = w1 * r1;
#pragma unroll
                for (int j = 0; j < 4; ++j) { if (s0 + j > t) w0[j] = 0.f; if (s0 + 4 + j > t) w1[j] = 0.f; }
                const v4u bw = (v4u){cvtpk(w0[0], w0[1]), cvtpk(w0[2], w0[3]), cvtpk(w1[0], w1[1]), cvtpk(w1[2], w1[3])};
                acc[i] = __builtin_amdgcn_mfma_f32_32x32x16_bf16(af, __builtin_bit_cast(bf16x8, bw), acc[i], 0, 0, 0);
            }
        }
    }
#pragma unroll
    for (int i = 0; i < 2; ++i) {
        const int t = 32 * (2 * th + i) + r; const float bias = sb[g * 128 + t]; bf16* urow = u + (t0 + t) * 1024 + c0;
#pragma unroll
        for (int q4 = 0; q4 < 4; ++q4) {
            const int d = 32 * db + 8 * q4 + 4 * h; const f32x4 sn = *(const f32x4*)(snorm + c0 + d);
            const u32x2 uw = *(const u32x2*)(urow + d);
            const float y0 = bflo(uw.x) * (acc[i][4 * q4] * sn[0] + bias), y1 = bfhi(uw.x) * (acc[i][4 * q4 + 1] * sn[1] + bias);
            const float y2 = bflo(uw.y) * (acc[i][4 * q4 + 2] * sn[2] + bias), y3 = bfhi(uw.y) * (acc[i][4 * q4 + 3] * sn[3] + bias);
            u32x2 yw; yw.x = cvtpk(y0, y1); yw.y = cvtpk(y2, y3); *(u32x2*)(urow + d) = yw;
        }
    }
    WG_BAR();
}

__device__ __forceinline__ void conv_unit(int ub, bf16* cb, const bf16* z, const float* cw  ) {
    const int tid = opaque_tid(), cc = tid & 127, rsub = tid >> 7; const int rbeg = ub * 64 + rsub * 16;
    float w0[8], w1[8], w2[8];
#pragma unroll
    for (int j = 0; j < 2; ++j) { const f32x4 a = *(const f32x4*)(cw + cc * 8 + 4 * j), b_ = *(const f32x4*)(cw + 1024 + cc * 8 + 4 * j), c = *(const f32x4*)(cw + 2048 + cc * 8 + 4 * j);
#pragma unroll
        for (int e = 0; e < 4; ++e) { w0[4 * j + e] = a[e]; w1[4 * j + e] = b_[e]; w2[4 * j + e] = c[e]; } }
    v4u zm2 = (v4u){0u, 0u, 0u, 0u}, zm1 = (v4u){0u, 0u, 0u, 0u};
    if ((rbeg & (SEQ - 1)) != 0) { zm2 = *(const v4u*)(z + (size_t)(rbeg - 2) * 1024 + cc * 8); zm1 = *(const v4u*)(z + (size_t)(rbeg - 1) * 1024 + cc * 8); }
#pragma unroll 4
    for (int i = 0; i < 16; ++i) {
        const size_t off = (size_t)(rbeg + i) * 1024 + cc * 8;
        const v4u zc = *(const v4u*)(z + off), cv = *(const v4u*)(cb + off); v4u yo;
#pragma unroll
        for (int e = 0; e < 4; ++e) {
            const float ylo = bflo(cv[e]) * (w0[2 * e] * bflo(zm2[e]) + w1[2 * e] * bflo(zm1[e]) + w2[2 * e] * bflo(zc[e]));
            const float yhi = bfhi(cv[e]) * (w0[2 * e + 1] * bfhi(zm2[e]) + w1[2 * e + 1] * bfhi(zm1[e]) + w2[2 * e + 1] * bfhi(zc[e]));
            yo[e] = cvtpk(ylo, yhi);
        }
        *(v4u*)(cb + off) = yo; zm2 = zm1; zm1 = zc;
    }
}

template <int MODE> __device__ __forceinline__ int dst_row(int n0, int row_off) {
    if (MODE == 1) { const int half = n0 >= DFF ? 1 : 0, jj = n0 - half * DFF; return (jj >> 7) * 256 + half * 128 + (jj & 127); }
    if (MODE == 2) { if (n0 < 6144 || n0 >= 8192) return n0; const int cc = n0 - 6144, half = cc >> 10, jj = cc & 1023; return 6144 + (jj >> 7) * 256 + half * 128 + (jj & 127); }
    return n0 + row_off;
}
__device__ __forceinline__ void tr_item(const float* W, int K, int N, bf16* WT, int drow0, const float* gain, LAS float* scr, int k0, int n0, int lane) {
#pragma unroll 8
    for (int i = 0; i < 32; ++i) { const int kk = 2 * i + (lane >> 5); scr[kk * 33 + (lane & 31)] = W[(size_t)(k0 + kk) * N + n0 + (lane & 31)]; }
    LDS_WAIT(); asm volatile("" ::: "memory");
    const int c = lane & 7;
    f32x4 g0 = (f32x4){1.f, 1.f, 1.f, 1.f}, g1 = g0;
    if (gain) { g0 = *(const f32x4*)(gain + k0 + 8 * c); g1 = *(const f32x4*)(gain + k0 + 8 * c + 4); }
#pragma unroll
    for (int j = 0; j < 4; ++j) { const int n = (lane >> 3) + 8 * j; const LAS float* s = scr + (8 * c) * 33 + n;
        v4u o; o.x = cvtpk(s[0 * 33] * g0[0], s[1 * 33] * g0[1]); o.y = cvtpk(s[2 * 33] * g0[2], s[3 * 33] * g0[3]); o.z = cvtpk(s[4 * 33] * g1[0], s[5 * 33] * g1[1]); o.w = cvtpk(s[6 * 33] * g1[2], s[7 * 33] * g1[3]);
        *(v4u*)(WT + (size_t)(drow0 + n) * K + k0 + 8 * c) = o; }
    LDS_WAIT(); asm volatile("" ::: "memory");
}
template <int MODE> __device__ __forceinline__ bool conv_try(int& r, const float* W, int K, int N, bf16* WT, int row_off, const float* gain, LAS float* scr, int lane) {
    const int nblk = N / 32, items = (K / 64) * nblk;
    if (r >= items) { r -= items; return false; }
    const int kb = r / nblk, nb = r - kb * nblk, n0 = nb * 32;
    tr_item(W, K, N, WT, dst_row<MODE>(n0, row_off), gain, scr, kb * 64, n0, lane);
    return true;
}
__device__ __forceinline__ void row_to_bf16_ss(const float* xrow, bf16* orow, float* ss_out, int lane) {
    const f32x4* xr = (const f32x4*)xrow + lane; f32x4 v[8]; float s = 0.f;
#pragma unroll
    for (int j = 0; j < 8; ++j) { v[j] = xr[64 * j]; s += (v[j].x * v[j].x + v[j].y * v[j].y) + (v[j].z * v[j].z + v[j].w * v[j].w); }
    s = wave_sum(s);
    u32x2* o8 = (u32x2*)orow + lane;
#pragma unroll
    for (int j = 0; j < 8; ++j) { u32x2 w; w.x = cvtpk(v[j].x, v[j].y); w.y = cvtpk(v[j].z, v[j].w); o8[64 * j] = w; }
    if (lane < 32) ss_out[lane] = (lane == 0) ? s : 0.f;
}

struct Args { const float* in[26]; float* out; unsigned char* ws; int ph_lo, ph_hi; };
constexpr int PH_INIT = 0, PH_KV = 1, PH_L0 = 2, PH_PER_LAYER = 12, PH_FINAL = PH_L0 + DEPTH * PH_PER_LAYER, N_PHASES = PH_FINAL + 1;
enum { I_X = 0, I_MEM, I_F1N, I_F1WI, I_F1WO, I_MIXN, I_MIXWI, I_LAMBDA, I_SUBLN, I_DIFFWO, I_SGUN, I_SGUWS, I_SGUB, I_SGUWO, I_CONVW, I_CONVWO, I_MIXWO, I_XN, I_MEMN, I_XWQ, I_XWKV, I_XWO, I_F2N, I_F2WI, I_F2WO, I_FINALN };

#define KAS __attribute__((address_space(4)))
__device__ __forceinline__ const KAS char* kargp() { const KAS char* p = (const KAS char*)__builtin_amdgcn_kernarg_segment_ptr(); asm volatile("" : "+s"(p)); return p; }
template <class T> __device__ __forceinline__ T karg(const KAS char* kp, int off) { return *(const KAS T*)(kp + off); }
constexpr int KOFF_OUT = 26 * 8, KOFF_WS = 27 * 8, KOFF_LO = 28 * 8, KOFF_HI = 28 * 8 + 4;
#define PH_ENV const KAS char* kp = kargp(); unsigned char* ws = karg<unsigned char*>(kp, KOFF_WS); (void)ws
#define KIN(i) karg<const float*>(kp, 8 * (i))
#define P_RP(k) ((float*)(ws + WS_RP) + (size_t)(k) * M * 32)
#define P_RPGV(l) ((float*)(ws + WS_RPGV) + (size_t)(l) * M * 16)
#define P_RPMEM ((float*)(ws + WS_RPMEM))
#define P_TAB ((LAS float*)(lds + RSTAB_OFF))
#define P_W(off) ((bf16*)(ws + WS_W + (off)))
#define P_WXKV ((bf16*)(ws + WS_WXKV))
#define P_H ((float*)(ws + WS_H))
#define P_HB ((bf16*)(ws + WS_HB))
#define P_MEMB ((bf16*)(ws + WS_MEMB))
#define P_KVX ((bf16*)(ws + WS_KVX))
#define P_QX ((bf16*)(ws + WS_QX))
#define P_HID ((bf16*)(ws + WS_HID))
#define P_QUC ((bf16*)(ws + WS_QUC))
#define P_KV2 ((bf16*)(ws + WS_KV2))
#define P_GVZ ((bf16*)(ws + WS_GVZ))
#define P_GATES ((bf16*)(ws + WS_GATES))
#define P_SCR ((float*)(ws + WS_SCR))
#define P_MERGED P_KV2

__global__ void __launch_bounds__(NTHREADS, 2) fwd_kernel(Args args_unused) {
    extern __shared__ __attribute__((aligned(16))) unsigned char lds_raw[];
    LAS unsigned char* lds = (LAS unsigned char*)lds_raw;
    volatile LAS unsigned* MISC = (volatile LAS unsigned*)(lds + MISC_OFF);
    const int G = gridDim.x, bx = blockIdx.x, vcu = (G % 8 == 0) ? (bx % 8) * (G / 8) + bx / 8 : bx;
    { const int tid0 = opaque_tid(); for (int u = tid0; u < (LDS_BYTES - LDSCTL_OFF) / 4; u += NTHREADS) ((LAS unsigned*)(lds + LDSCTL_OFF))[u] = 0u; }
    __syncthreads();
    int lo, hi; XcdBarrier bar;
    { PH_ENV; lo = karg<int>(kp, KOFF_LO); hi = karg<int>(kp, KOFF_HI);
      bar.bar = (unsigned*)(ws + WS_CTL) + 4096; bar.x = 0; bar.st = nullptr;
      if (hi - lo > 1) bar = xcd_barrier_post((unsigned*)(ws + WS_CTL) + 4096, MISC + 8); }
#define IN(k) (lo <= (k) && (k) < hi)
#define SEAM(k) do { if (IN(k) && IN((k) + 1)) xcd_barrier(bar); } while (0)
    constexpr size_t PL = (size_t)M * 1024;
    const int NGW = G * NWAVES;
#define WAVE_ENV const int tid = opaque_tid(), lane = tid & 63, wave = __builtin_amdgcn_readfirstlane(tid >> 6), gw = vcu * NWAVES + wave; LAS float* scr = (LAS float*)(lds + RING_OFF + wave * 16384); (void)lane; (void)gw; (void)scr

#define PREP_LAYER(l) do { \
        const float* f1wi = KIN(I_F1WI) + (size_t)(l) * D * NFFIN; const float* f1wo = KIN(I_F1WO) + (size_t)(l) * DFF * D; \
        const float* f2wi = KIN(I_F2WI) + (size_t)(l) * D * NFFIN; const float* f2wo = KIN(I_F2WO) + (size_t)(l) * DFF * D; \
        const float* mwi = KIN(I_MIXWI) + (size_t)(l) * D * NMIX; const float* dwo = KIN(I_DIFFWO) + (size_t)(l) * 1024 * D; const float* swo = KIN(I_SGUWO) + (size_t)(l) * 1024 * D; \
        const float* cwo = KIN(I_CONVWO) + (size_t)(l) * 1024 * D; const float* mwo = KIN(I_MIXWO) + (size_t)(l) * D * D; const float* xwq = KIN(I_XWQ) + (size_t)(l) * D * 512; const float* xwo = KIN(I_XWO) + (size_t)(l) * 512 * D; \
        constexpr int NIT = 2 * ((D / 64) * (NFFIN / 32) + (DFF / 64) * (D / 32)) + (D / 64) * (NMIX / 32) + 3 * (1024 / 64) * (D / 32) + (D / 64) * (D / 32) + (D / 64) * (512 / 32) + (512 / 64) * (D / 32); \
        for (int it = gw; it < NIT; it += NGW) { int r_ = it; \
            if (conv_try<1>(r_, f1wi, D, NFFIN, P_W(W_F1IN), 0, KIN(I_F1N) + (l) * D, scr, lane)) continue; \
            if (conv_try<1>(r_, f2wi, D, NFFIN, P_W(W_F2IN), 0, KIN(I_F2N) + (l) * D, scr, lane)) continue; \
            if (conv_try<2>(r_, mwi, D, NMIX, P_W(W_MIXIN), 0, KIN(I_MIXN) + (l) * D, scr, lane)) continue; \
            if (conv_try<0>(r_, f1wo, DFF, D, P_W(W_F1OUT), 0, nullptr, scr, lane)) continue; \
            if (conv_try<0>(r_, f2wo, DFF, D, P_W(W_F2OUT), 0, nullptr, scr, lane)) continue; \
            if (conv_try<0>(r_, dwo, 1024, D, P_W(W_BR3), 0, nullptr, scr, lane)) continue; \
            if (conv_try<0>(r_, swo, 1024, D, P_W(W_BR3), 2048, nullptr, scr, lane)) continue; \
            if (conv_try<0>(r_, cwo, 1024, D, P_W(W_BR3), 4096, nullptr, scr, lane)) continue; \
            if (conv_try<0>(r_, mwo, D, D, P_W(W_MO), 0, nullptr, scr, lane)) continue; \
            if (conv_try<0>(r_, xwq, D, 512, P_W(W_XQ), 0, KIN(I_XN) + (l) * D, scr, lane)) continue; \
            conv_try<0>(r_, xwo, 512, D, P_W(W_XO), 0, nullptr, scr, lane); } } while (0)

    if (IN(PH_INIT)) { PH_ENV; WAVE_ENV;
        for (int m = gw; m < M; m += NGW) row_to_bf16_ss(KIN(I_X) + (size_t)m * D, P_HB + (size_t)m * D, P_RP(0) + (size_t)m * 32, lane);
        for (int m = gw; m < MMEM; m += NGW) row_to_bf16_ss(KIN(I_MEM) + (size_t)m * D, P_MEMB + (size_t)m * D, P_RPMEM + (size_t)m * 32, lane);
        { constexpr int NIT = DEPTH * (D / 64) * (1024 / 32);
          for (int it = gw; it < NIT; it += NGW) { int r_ = it;
#pragma unroll
              for (int l = 0; l < DEPTH; ++l) if (conv_try<0>(r_, KIN(I_XWKV) + (size_t)l * D * 1024, D, 1024, P_WXKV, l * 1024, KIN(I_MEMN) + l * D, scr, lane)) break; } }
        PREP_LAYER(0);
    }
    SEAM(PH_INIT);
    if (IN(PH_KV)) { PH_ENV;
        pg8::Gemm g{P_MEMB, P_WXKV, MMEM, 4096, D}; pg8::StaticOrder S; S.init(MMEM, 4096, G, bx);
        ep::EpiScale E{P_RPMEM, P_TAB, P_KVX, 4096, 1.0f};
        pg8::gemm_phase<ep::EpiScale, pg8::StaticOrder, true, true>(lds + RING_OFF, g, S, E);
    }
    SEAM(PH_KV);

    for (int l = 0; l < DEPTH; ++l) {
        const int P = PH_L0 + l * PH_PER_LAYER;
        if (IN(P + 0) && l > 0) { PH_ENV; WAVE_ENV; PREP_LAYER(l); }
        if (l > 0) SEAM(P + 0);
        if (IN(P + 1)) { PH_ENV;
            pg8::Gemm g{P_HB, P_W(W_F1IN), M, NFFIN, D}; pg8::StaticOrder S; S.init(M, NFFIN, G, bx);
            ep::EpiFfnIn E{P_RP(4 * l + 0), P_TAB, P_HID};
            pg8::gemm_phase<ep::EpiFfnIn, pg8::StaticOrder, true, true>(lds + RING_OFF, g, S, E);
        }
        SEAM(P + 1);
        if (IN(P + 2)) { PH_ENV;
            pg8::Gemm g{P_HID, P_W(W_F1OUT), M, D, DFF}; pg8::StaticOrder S; S.init(M, D, G, bx);
            ep::EpiResid E{l == 0 ? KIN(I_X) : P_H, P_H, P_HB, P_RP(4 * l + 1), 0.5f};
            pg8::gemm_phase<ep::EpiResid, pg8::StaticOrder, true, true>(lds + RING_OFF, g, S, E);
        }
        SEAM(P + 2);
        if (IN(P + 3)) { PH_ENV;
            pg8::Gemm g{P_HB, P_W(W_MIXIN), M, NMIX, D}; pg8::StaticOrder S; S.init(M, NMIX, G, bx);
            ep::EpiMixIn E{P_RP(4 * l + 1), P_TAB, P_RPGV(l), P_QUC, P_KV2, P_GVZ, P_GATES};
            pg8::gemm_phase<ep::EpiMixIn, pg8::StaticOrder, true, true>(lds + RING_OFF, g, S, E);
        }
        SEAM(P + 3);
        if (IN(P + 4)) { PH_ENV; WAVE_ENV;
            LAS float* lamp = (LAS float*)(lds + RING_OFF + 65536);
            const float lam_init = 0.8f - 0.6f * expf(-0.3f * (float)l);
            if (wave == 0) { const float* lp = KIN(I_LAMBDA) + l * 256; const float a = wave_sum(lp[lane] * lp[64 + lane]), b_ = wave_sum(lp[128 + lane] * lp[192 + lane]);
                if (lane == 0) lamp[0] = expf(a) - expf(b_) + lam_init; }
            WG_BAR();
            const float lam = lamp[0];
            WG_BAR();
            for (int i = 0; i < 4; ++i) {
                for (int uu = vcu; uu < 256; uu += G) {
                    const int bh = uu >> 1, s = uu & 1; const int qb = (i == 0) ? s : (i == 1) ? 7 - s : (i == 2) ? 2 + s : 5 - s;
                    diff_attn_unit(bh >> 3, bh & 7, qb, P_QUC, P_KV2, P_KV2 + PL, KIN(I_SUBLN) + l * 128, lam, 1.0f - lam_init, lds + RING_OFF);
                }
            }
            for (int uu = vcu * 8; uu < 2048; uu += G * 8)
                for (int j = 0; j < 8; ++j) { const int id = uu + j; sgu_unit(id >> 7, (id >> 3) & 15, id & 7, P_QUC + PL, P_GVZ, P_RPGV(l), KIN(I_SGUWS) + (size_t)l * 8 * 128 * 128, KIN(I_SGUB) + l * 8 * 128, KIN(I_SGUN) + l * 1024, lds + RING_OFF); }
            for (int uu = vcu; uu < M / 64; uu += G) conv_unit(uu, P_QUC + 2 * PL, P_GVZ + PL, KIN(I_CONVW) + l * 3 * 1024);
        }
        SEAM(P + 4);
        if (IN(P + 5)) { PH_ENV;
            pg8::Gemm g{P_QUC, P_W(W_BR3), 3 * M, 3 * D, 1024}; ep::TripleOrder S; S.base.init(M, D, G, bx);
            ep::EpiMerge E{P_GATES, P_SCR, P_MERGED};
            pg8::gemm_phase<ep::EpiMerge, ep::TripleOrder, true, true>(lds + RING_OFF, g, S, E);
        }
        SEAM(P + 5);
        if (IN(P + 6)) { PH_ENV;
            pg8::Gemm g{P_MERGED, P_W(W_MO), M, D, D}; pg8::StaticOrder S; S.init(M, D, G, bx);
            ep::EpiResid E{P_H, P_H, P_HB, P_RP(4 * l + 2), 1.0f};
            pg8::gemm_phase<ep::EpiResid, pg8::StaticOrder, true, true>(lds + RING_OFF, g, S, E);
        }
        SEAM(P + 6);
        if (IN(P + 7)) { PH_ENV;
            pg8::Gemm g{P_HB, P_W(W_XQ), M, 512, D}; pg8::StaticOrder S; S.init(M, 512, G, bx);
            ep::EpiScale E{P_RP(4 * l + 2), P_TAB, P_QX, 512, QSCALE_MEM};
            pg8::gemm_phase<ep::EpiScale, pg8::StaticOrder, true, true>(lds + RING_OFF, g, S, E);
        }
        SEAM(P + 7);
        if (IN(P + 8)) { PH_ENV;
            for (int uu = vcu * 2; uu < 512; uu += G * 2)
                for (int j = 0; j < 2; ++j) { const int id = uu + j; mem_attn_unit(id >> 5, (id >> 3) & 3, id & 7, P_QX, P_KVX + l * 1024, lds + RING_OFF); }
        }
        SEAM(P + 8);
        if (IN(P + 9)) { PH_ENV;
            pg8::Gemm g{P_QX, P_W(W_XO), M, D, 512}; pg8::StaticOrder S; S.init(M, D, G, bx);
            ep::EpiResid E{P_H, P_H, P_HB, P_RP(4 * l + 3), 1.0f};
            pg8::gemm_phase<ep::EpiResid, pg8::StaticOrder, true, true>(lds + RING_OFF, g, S, E);
        }
        SEAM(P + 9);
        if (IN(P + 10)) { PH_ENV;
            pg8::Gemm g{P_HB, P_W(W_F2IN), M, NFFIN, D}; pg8::StaticOrder S; S.init(M, NFFIN, G, bx);
            ep::EpiFfnIn E{P_RP(4 * l + 3), P_TAB, P_HID};
            pg8::gemm_phase<ep::EpiFfnIn, pg8::StaticOrder, true, true>(lds + RING_OFF, g, S, E);
        }
        SEAM(P + 10);
        if (IN(P + 11)) { PH_ENV;
            pg8::Gemm g{P_HID, P_W(W_F2OUT), M, D, DFF}; pg8::StaticOrder S; S.init(M, D, G, bx);
            ep::EpiResid E{P_H, P_H, P_HB, P_RP(4 * l + 4), 0.5f};
            pg8::gemm_phase<ep::EpiResid, pg8::StaticOrder, true, true>(lds + RING_OFF, g, S, E);
        }
        SEAM(P + 11);
    }
    if (IN(PH_FINAL)) { PH_ENV; WAVE_ENV;
        const float* rp16 = P_RP(16); const float* gfin = KIN(I_FINALN);
        for (int m = gw; m < M; m += NGW) {
            const float ssum = wave_sum(lane < 32 ? rp16[(size_t)m * 32 + lane] : 0.f);
            const float rstd = rsqf_(ssum * (1.0f / D) + EPS);
            const f32x4* hr = (const f32x4*)(P_H + (size_t)m * D) + lane; f32x4* orow = (f32x4*)(karg<float*>(kp, KOFF_OUT) + (size_t)m * D) + lane; const f32x4* gr = (const f32x4*)gfin + lane;
#pragma unroll
            for (int j = 0; j < 8; ++j) orow[64 * j] = hr[64 * j] * rstd * gr[64 * j];
        }
    }
#undef IN
#undef SEAM
#undef PREP_LAYER
}

#ifndef MK_SPLIT
#define MK_SPLIT 0
#endif
extern "C" void kernel_launch(void* const* d_in, const int* in_sizes, int n_in, void* d_out, int out_size, void* d_ws, size_t ws_size, hipStream_t stream) {
    static int grid = 0;
    if (grid == 0) {
        if (n_in != 26 || out_size != M * D || ws_size < WS_END) { fprintf(stderr, "kernel_launch: unexpected shapes: n_in %d out %d ws %zu (need %zu)\n", n_in, out_size, ws_size, (size_t)WS_END); grid = -1; return; }
        int dev = 0, cus = 0, per_cu = 0;
        if (hipGetDevice(&dev) != hipSuccess || hipDeviceGetAttribute(&cus, hipDeviceAttributeMultiprocessorCount, dev) != hipSuccess) { grid = -1; return; }
        if (hipFuncSetAttribute((const void*)fwd_kernel, hipFuncAttributeMaxDynamicSharedMemorySize, LDS_BYTES) != hipSuccess) { fprintf(stderr, "kernel_launch: hipFuncSetAttribute failed\n"); grid = -1; return; }
        if (hipOccupancyMaxActiveBlocksPerMultiprocessor(&per_cu, (const void*)fwd_kernel, NTHREADS, LDS_BYTES) != hipSuccess || per_cu < 1) fprintf(stderr, "kernel_launch: occupancy query says %d\n", per_cu);
        (void)hipGetLastError();
        grid = cus;
    }
    if (grid < 0) return;
    (void)in_sizes;
    if (hipMemsetAsync((char*)d_ws, 0, ZERO_BYTES, stream) != hipSuccess) { fprintf(stderr, "kernel_launch: memset failed\n"); return; }
    Args a{};
    for (int i = 0; i < 26; ++i) a.in[i] = (const float*)d_in[i];
    a.out = (float*)d_out; a.ws = (unsigned char*)d_ws;
#if MK_SPLIT
    for (int p = 0; p < N_PHASES; ++p) { a.ph_lo = p; a.ph_hi = p + 1; hipLaunchKernelGGL(fwd_kernel, dim3(grid), dim3(NTHREADS), LDS_BYTES, stream, a); }
#else
    a.ph_lo = 0; a.ph_hi = N_PHASES;
    hipLaunchKernelGGL(fwd_kernel, dim3(grid), dim3(NTHREADS), LDS_BYTES, stream, a);
#endif
    const hipError_t le = hipPeekAtLastError();
    if (le != hipSuccess) fprintf(stderr, "kernel_launch: launch failed: %s\n", hipGetErrorName(le));
}
```

```cpp
#include <hip/hip_runtime.h>
#include <hip/hip_bf16.h>
#include <cstdio>
#include <cstdint>
#include <cmath>
namespace pg8 {
#define PG8_LAS __attribute__((address_space(3)))
typedef unsigned short bf16_t;
typedef short bf16x8 __attribute__((ext_vector_type(8)));
typedef float f32x4 __attribute__((ext_vector_type(4)));
typedef unsigned u32x4 __attribute__((ext_vector_type(4)));
constexpr int BM = 256, BK = 64, HALF = 128, HTB = HALF * BK * 2  , STAGE_BYTES = 8 * HTB, NXCD = 8, WGM = 4;

__host__ __device__ __forceinline__ int lds_byte(int r, int c) { const int st = (r >> 4) * 2 + (c >> 5), rr = r & 15, cc = c & 31, ob = rr * 64 + cc * 2; return st * 1024 + (ob ^ (((ob >> 9) & 1) << 5)); }
__host__ __device__ __forceinline__ void stage_rc(int b, int& R, int& C) { const int st = b / 1024, sb = b % 1024, swz = sb ^ (((sb >> 9) & 1) << 5); R = (st >> 1) * 16 + swz / 64; C = (st & 1) * 32 + (swz % 64) / 2; }
__host__ __device__ __forceinline__ int perm32(int rho) { const int n = rho >> 4, i = rho & 15; return 8 * (i >> 2) + 4 * n + (i & 3); }

struct Unit { int pm, pn; };
struct Gemm { const bf16_t* A; const bf16_t* Bt; int M, N, K; int a_tiles = 0; };

struct StaticOrder {
    int nM, nN, nwg, G, c;
    __host__ __device__ void init(int M, int N, int G_, int c_) { nM = M / BM; nN = N / BM; nwg = nM * nN; G = G_; c = c_; }
    __host__ __device__ __forceinline__ bool next(int i, Unit& u) const {
        const long L = (long)i * G + c; if (L >= nwg) return false;
        int wgid = (int)L; { const int q = nwg / NXCD, r = nwg % NXCD, xcd = wgid % NXCD, off = wgid / NXCD; wgid = (xcd < r ? xcd * (q + 1) : r * (q + 1) + (xcd - r) * q) + off; }
        const int nig = WGM * nN, gid = wgid / nig, fm = gid * WGM, gsz = (nM - fm) < WGM ? (nM - fm) : WGM;
        u.pm = fm + ((wgid % nig) % gsz); u.pn = (wgid % nig) / gsz; return true;
    }
    __device__ __forceinline__ void a_ready(const Unit&) const {}
    __device__ __forceinline__ void done(const Unit&) const {}
};
__device__ __forceinline__ unsigned cvt_pk_bf16(float lo, float hi) { unsigned r; asm volatile("v_cvt_pk_bf16_f32 %0, %1, %2" : "=v"(r) : "v"(lo), "v"(hi)); return r; }
typedef float f32x2 __attribute__((ext_vector_type(2)));
__device__ __forceinline__ f32x2 gelu_pk(f32x2 v) {
    const f32x2 av = __builtin_elementwise_abs(v), d = av * 0.2316418882f + 1.0f;
    f32x2 t; t.x = __builtin_amdgcn_rcpf(d.x); t.y = __builtin_amdgcn_rcpf(d.y);
    f32x2 q = t * 0.5307027145f + (-0.7265760135f); q = q * t + 0.7107068705f; q = q * t + (-0.142248368f); q = q * t + 0.127414796f; q = q * t;
    const f32x2 s = (v * v) * (-0.72134752044f);
    f32x2 e; e.x = __builtin_amdgcn_exp2f(s.x); e.y = __builtin_amdgcn_exp2f(s.y);
    const f32x2 m = v * (q * e), r = v - m;
    f32x2 o; o.x = v.x < 0.f ? m.x : r.x; o.y = v.y < 0.f ? m.y : r.y; return o;
}
template <class Epi, class Sched, bool ALIGN_EPI = false, bool SP2 = false>
__device__ __forceinline__ void gemm_phase(PG8_LAS unsigned char* lds, const Gemm g, const Sched& S, const Epi& E) {
    int tid_ = threadIdx.x; asm volatile("" : "+v"(tid_));
    const int tid = tid_, wid = __builtin_amdgcn_readfirstlane(tid >> 6), lane = tid & 63, wr = wid >> 2, wc = wid & 3, fr = lane & 15, fq = lane >> 4;
    const int K = g.K, nt = K / BK;
    unsigned voffA[2], voffB[2];
#pragma unroll
    for (int i = 0; i < 2; ++i) { int R, C; stage_rc(tid * 16 + i * 8192, R, C); const int Rb = Epi::PERM ? ((R & ~31) + perm32(R & 31)) : R;
        voffA[i] = Epi::A_TILED ? (unsigned)(R * BK + C) * 2u : (unsigned)(R * K + C) * 2u; voffB[i] = (unsigned)(Rb * K + C) * 2u; }
    const size_t kstep = (size_t)(BK * 2);
    const size_t hstep = (size_t)HALF * K * 2;
    const size_t tstep = 2 * hstep;
    const size_t kstepA = Epi::A_TILED ? (size_t)(2 * HALF * BK * 2) : kstep, hstepA = Epi::A_TILED ? (size_t)(HALF * BK * 2) : hstep, tstepA = Epi::A_TILED ? (size_t)(g.a_tiles ? g.a_tiles : nt) * kstepA : tstep;
    const unsigned ldsw = (unsigned)wid * 1024u;
    const int aoff = lds_byte(wr * 64 + fr, fq * 8), boff = lds_byte(wc * 32 + fr, fq * 8);
#define PG8_SA(b, h) (((b) * 2 + (h)) * HTB)
#define PG8_SB(b, h) ((4 + (b) * 2 + (h)) * HTB)
#define PG8_STAGE(bufoff, gbase, voff) do { _Pragma("unroll") for (int _i = 0; _i < 2; ++_i) \
        __builtin_amdgcn_global_load_lds((const unsigned*)((const char*)(gbase) + (voff)[_i]), (PG8_LAS unsigned*)(lds + (bufoff) + ldsw + _i * 8192), 16, 0, 0); } while (0)
#define PG8_STAGE_A(bufoff, gbase, voff) do { _Pragma("unroll") for (int _i = 0; _i < 2; ++_i) \
        __builtin_amdgcn_global_load_lds((const unsigned*)((const char*)(gbase) + (voff)[_i]), (PG8_LAS unsigned*)(lds + (bufoff) + ldsw + _i * 8192), 16, 0, Epi::A_AUX); } while (0)
#define PG8_LDA(dst, b, h) do { _Pragma("unroll") for (int m = 0; m < 4; ++m) _Pragma("unroll") for (int k = 0; k < 2; ++k) dst[m][k] = *(const PG8_LAS bf16x8*)(lds + PG8_SA(b, h) + aoff + m * 2048 + k * 1024); } while (0)
#define PG8_LDB(dst, b, h) do { _Pragma("unroll") for (int n = 0; n < 2; ++n) _Pragma("unroll") for (int k = 0; k < 2; ++k) dst[n][k] = *(const PG8_LAS bf16x8*)(lds + PG8_SB(b, h) + boff + n * 2048 + k * 1024); } while (0)
#define PG8_MMA(ai, bj, At, Bt) do { __builtin_amdgcn_s_setprio(1); _Pragma("unroll") for (int m = 0; m < 4; ++m) _Pragma("unroll") for (int n = 0; n < 2; ++n) _Pragma("unroll") for (int k = 0; k < 2; ++k) \
        acc[ai][bj][m][n] = __builtin_amdgcn_mfma_f32_16x16x32_bf16(Bt[n][k], At[m][k], acc[ai][bj][m][n], 0, 0, 0); __builtin_amdgcn_s_setprio(0); } while (0)
#define PG8_WAIT_V(n) asm volatile("s_waitcnt vmcnt(" #n ")" ::: "memory")
#define PG8_WAIT_L(n) asm volatile("s_waitcnt lgkmcnt(" #n ")" ::: "memory")
#define PG8_BAR __builtin_amdgcn_s_barrier()
#define PG8_SCHED __builtin_amdgcn_sched_barrier(0)
    Unit cur, nxt; int ui = 0;
    if (!S.next(0, cur)) return;
    f32x4 acc[2][2][4][2];
#pragma unroll
    for (int a = 0; a < 2; ++a)
#pragma unroll
        for (int b = 0; b < 2; ++b)
#pragma unroll
            for (int m = 0; m < 4; ++m)
#pragma unroll
                for (int n = 0; n < 2; ++n) acc[a][b][m][n] = (f32x4){0.f, 0.f, 0.f, 0.f};
    bf16x8 At[4][2], B0[2][2], B1[2][2];
    const char* cA = (const char*)g.A + (size_t)cur.pm * tstepA; const char* cB = (const char*)g.Bt + (size_t)cur.pn * tstep;
    S.a_ready(cur);
    E.prime(cur, wr, wc, fr, fq);
    if constexpr (SP2) {
        PG8_STAGE(PG8_SB(0, 0), cB, voffB); PG8_STAGE(PG8_SB(0, 1), cB + hstep, voffB); PG8_STAGE_A(PG8_SA(0, 0), cA, voffA); PG8_STAGE_A(PG8_SA(0, 1), cA + hstepA, voffA);
        if (wr == 1) PG8_BAR;
        PG8_WAIT_V(2); PG8_BAR;
        PG8_STAGE(PG8_SB(1, 0), cB + kstep, voffB); PG8_STAGE_A(PG8_SA(1, 0), cA + kstepA, voffA); PG8_STAGE(PG8_SB(1, 1), cB + hstep + kstep, voffB);
        PG8_WAIT_V(6); PG8_BAR;
    } else {
        PG8_STAGE(PG8_SB(0, 0), cB, voffB); PG8_STAGE_A(PG8_SA(0, 0), cA, voffA); PG8_STAGE(PG8_SB(0, 1), cB + hstep, voffB); PG8_STAGE_A(PG8_SA(0, 1), cA + hstepA, voffA);
        if (wr == 1) PG8_BAR;
        PG8_WAIT_V(4); PG8_BAR;
        PG8_STAGE(PG8_SB(1, 0), cB + kstep, voffB); PG8_STAGE_A(PG8_SA(1, 0), cA + kstepA, voffA); PG8_STAGE(PG8_SB(1, 1), cB + hstep + kstep, voffB);
        PG8_WAIT_V(6); PG8_BAR;
    }
    for (;;) {
        const bool has_next = S.next(ui + 1, nxt);
        const char* nA = has_next ? (const char*)g.A + (size_t)nxt.pm * tstepA : cA; const char* nB = has_next ? (const char*)g.Bt + (size_t)nxt.pn * tstep : cB;
        for (int t = 0; t < nt; t += 2) {
            const bool last = (t == nt - 2);
            const char* a1 = cA + (size_t)(t + 1) * kstepA;
            const char* a2 = last ? nA : cA + (size_t)(t + 2) * kstepA; const char* b2 = last ? nB : cB + (size_t)(t + 2) * kstep;
            const char* a3 = a2 + kstepA; const char* b3 = b2 + kstep;
            if (last && has_next) S.a_ready(nxt);
            if constexpr (Epi::KHOOK) { if (t == Epi::KH0 || t == Epi::KH1) { if (wr == 0) PG8_BAR;
                E.khook(acc, cur, t, wr, wc, fr, fq); if (wr == 1) PG8_BAR; } }
            if constexpr (SP2) {
            PG8_LDB(B0, 0, 0); PG8_LDB(B1, 0, 1); PG8_SCHED; PG8_LDA(At, 0, 0); PG8_STAGE_A(PG8_SA(1, 1), a1 + hstepA, voffA);
            PG8_WAIT_V(8); PG8_WAIT_L(0); PG8_BAR; PG8_MMA(0, 0, At, B0); PG8_MMA(0, 1, At, B1); PG8_BAR; PG8_SCHED;
            PG8_LDA(At, 0, 1); PG8_STAGE(PG8_SB(0, 0), b2, voffB); PG8_STAGE(PG8_SB(0, 1), b2 + hstep, voffB); PG8_STAGE_A(PG8_SA(0, 0), a2, voffA);
            PG8_WAIT_V(8); PG8_WAIT_L(0); PG8_BAR; PG8_MMA(1, 0, At, B0); PG8_MMA(1, 1, At, B1); PG8_BAR; PG8_SCHED;
            PG8_LDB(B0, 1, 0); PG8_LDB(B1, 1, 1); PG8_SCHED; PG8_LDA(At, 1, 0); PG8_STAGE_A(PG8_SA(0, 1), a2 + hstepA, voffA);
            PG8_WAIT_V(8); PG8_WAIT_L(0); PG8_BAR; PG8_MMA(0, 0, At, B0); PG8_MMA(0, 1, At, B1); PG8_BAR; PG8_SCHED;
            PG8_LDA(At, 1, 1); PG8_STAGE(PG8_SB(1, 0), b3, voffB); PG8_STAGE(PG8_SB(1, 1), b3 + hstep, voffB); PG8_STAGE_A(PG8_SA(1, 0), a3, voffA);
            PG8_WAIT_V(8); PG8_WAIT_L(0); PG8_BAR; PG8_MMA(1, 0, At, B0); PG8_MMA(1, 1, At, B1); PG8_BAR; PG8_SCHED;
            } else {
            PG8_LDB(B0, 0, 0); PG8_SCHED; PG8_LDA(At, 0, 0); PG8_STAGE_A(PG8_SA(1, 1), a1 + hstepA, voffA);
            PG8_WAIT_L(8); PG8_BAR; PG8_WAIT_L(0); PG8_MMA(0, 0, At, B0); PG8_BAR; PG8_SCHED;
            PG8_LDB(B1, 0, 1); PG8_STAGE(PG8_SB(0, 0), b2, voffB);
            PG8_BAR; PG8_WAIT_L(0); PG8_MMA(0, 1, At, B1); PG8_BAR;
            PG8_LDA(At, 0, 1); PG8_STAGE_A(PG8_SA(0, 0), a2, voffA);
            PG8_BAR; PG8_WAIT_L(0); PG8_MMA(1, 0, At, B0); PG8_BAR; PG8_SCHED;
            PG8_STAGE(PG8_SB(0, 1), b2 + hstep, voffB);
            PG8_WAIT_V(6); PG8_BAR; PG8_MMA(1, 1, At, B1); PG8_BAR;
            PG8_LDB(B0, 1, 0); PG8_SCHED; PG8_LDA(At, 1, 0); PG8_STAGE_A(PG8_SA(0, 1), a2 + hstepA, voffA);
            PG8_WAIT_L(8); PG8_BAR; PG8_WAIT_L(0); PG8_MMA(0, 0, At, B0); PG8_BAR; PG8_SCHED;
            PG8_LDB(B1, 1, 1); PG8_STAGE(PG8_SB(1, 0), b3, voffB);
            PG8_BAR; PG8_WAIT_L(0); PG8_MMA(0, 1, At, B1); PG8_BAR;
            PG8_LDA(At, 1, 1); PG8_STAGE_A(PG8_SA(1, 0), a3, voffA);
            PG8_BAR; PG8_WAIT_L(0); PG8_MMA(1, 0, At, B0); PG8_BAR; PG8_SCHED;
            PG8_STAGE(PG8_SB(1, 1), b3 + hstep, voffB);
            PG8_WAIT_V(6); PG8_BAR; PG8_MMA(1, 1, At, B1); PG8_BAR;
            }
        }
        if constexpr (ALIGN_EPI) { if (wr == 0) PG8_BAR; }
        if constexpr (!Epi::AFTER_DRAIN) { E(acc, cur, wr, wc, fr, fq, ui, has_next, nxt); S.done(cur); }
        if (!has_next) break;
#pragma unroll
        for (int a = 0; a < 2; ++a)
#pragma unroll
            for (int b = 0; b < 2; ++b)
#pragma unroll
                for (int m = 0; m < 4; ++m)
#pragma unroll
                    for (int n = 0; n < 2; ++n) acc[a][b][m][n] = (f32x4){0.f, 0.f, 0.f, 0.f};
        cur = nxt; cA = nA; cB = nB; ++ui;
        if constexpr (ALIGN_EPI) { if (wr == 1) PG8_BAR; }
    }
    PG8_WAIT_V(0);
    if constexpr (!ALIGN_EPI) { if (wr == 0) PG8_BAR; }
    PG8_BAR;
    if constexpr (Epi::AFTER_DRAIN) { E.fused(acc, cur, wr, wc, fr, fq, lds, wid, lane); S.done(cur); }
#undef PG8_SA
#undef PG8_SB
#undef PG8_STAGE
#undef PG8_LDA
#undef PG8_LDB
#undef PG8_MMA
#undef PG8_WAIT_V
#undef PG8_WAIT_L
#undef PG8_BAR
#undef PG8_SCHED
}
}
#define GAS __attribute__((address_space(1)))
#define LAS __attribute__((address_space(3)))
typedef unsigned short bf16;
typedef unsigned v4u __attribute__((ext_vector_type(4)));
typedef float f32x4 __attribute__((ext_vector_type(4)));
typedef short bf16x8 __attribute__((ext_vector_type(8)));
typedef GAS unsigned gu32;
typedef GAS unsigned long long gu64;
#define RLX_AGENT __ATOMIC_RELAXED, __HIP_MEMORY_SCOPE_AGENT
#define LDS_WAIT() asm volatile("s_waitcnt lgkmcnt(0)" ::: "memory")
#define VM_WAIT() asm volatile("s_waitcnt vmcnt(0)" ::: "memory")
__device__ __forceinline__ unsigned long long rt() { return __builtin_amdgcn_s_memrealtime(); }
__device__ __forceinline__ unsigned f2bf(float f) { unsigned u = __builtin_bit_cast(unsigned, f); return (u + 0x7fffu + ((u >> 16) & 1u)) >> 16; }
__device__ __forceinline__ unsigned pk2(float lo, float hi) { return f2bf(lo) | (f2bf(hi) << 16); }
#define XB_TMO      128
#define XB_XCNT(j)  (256  + 64 * (j))
#define XB_XSUB(j)  (1280 + 64 * (j))
#define XB_XGEN(j)  (2304 + 64 * (j))
#define XB_TOP      3328
#define XB_TOPGEN   3392
#define XCD_BAR_WORDS 3456
#define XB_SPIN_CAP (1u << 18)

__device__ __forceinline__ unsigned xb_ld(unsigned* p)              { return __hip_atomic_load(p, __ATOMIC_RELAXED, __HIP_MEMORY_SCOPE_AGENT); }
__device__ __forceinline__ unsigned xb_add(unsigned* p, unsigned v) { return __hip_atomic_fetch_add(p, v, __ATOMIC_RELAXED, __HIP_MEMORY_SCOPE_AGENT); }
__device__ __forceinline__ unsigned xb_xcc_id() { return (unsigned)__builtin_amdgcn_s_getreg((3 << 11) | 20) & 0xFu; }
#define XB_SPIN(cond, bar) do { unsigned _sp = 0; while (cond) { __builtin_amdgcn_s_sleep(1); \
    if ((++_sp & 255u) == 0u) { if (xb_ld(&(bar)[XB_TMO])) break; if (_sp > XB_SPIN_CAP) { atomicAdd(&(bar)[XB_TMO], 1u); break; } } } } while (0)

struct XcdBarrier {
    unsigned* bar; unsigned x;
    volatile LAS unsigned* st;
};

__device__ __forceinline__ XcdBarrier xcd_barrier_post(unsigned* bar, volatile LAS unsigned* st) {
    XcdBarrier b; b.bar = bar; b.x = xb_xcc_id(); b.st = st;
    if (threadIdx.x == 0) (void)xb_add(&bar[XB_XCNT(b.x)], 1u);
    return b;
}
__device__ __forceinline__ void xcd_barrier_complete(unsigned* bar, unsigned x, unsigned& nloc, unsigned& nx) {
    const unsigned G = gridDim.x * gridDim.y * gridDim.z;
    unsigned sum, cnt, mine, sp = 0u;
    for (;;) {
        sum = 0u; cnt = 0u; mine = 0u;
#pragma unroll
        for (unsigned j = 0; j < 16; ++j) { const unsigned c = xb_ld(&bar[XB_XCNT(j)]); sum += c; cnt += (c > 0u) ? 1u : 0u; mine = (j == x) ? c : mine; }
        if (sum == G) break;
        __builtin_amdgcn_s_sleep(1);
        if ((++sp & 255u) == 0u) { if (xb_ld(&bar[XB_TMO])) break; if (sp > XB_SPIN_CAP) { atomicAdd(&bar[XB_TMO], 1u); break; } }
    }
    nloc = mine > 0u ? mine : 1u; nx = cnt > 0u ? cnt : 1u;
}

__device__ __forceinline__ void xcd_barrier(const XcdBarrier& b) {
    asm volatile("s_waitcnt vmcnt(0)" ::: "memory");
    __syncthreads();
    if (threadIdx.x == 0) {
        unsigned* bar = b.bar;
        __builtin_amdgcn_s_waitcnt(0);
        unsigned nloc = b.st[0], nx = b.st[1];
        if (nloc == 0u) { xcd_barrier_complete(bar, b.x, nloc, nx); b.st[0] = nloc; b.st[1] = nx; }
        const unsigned old = xb_add(&bar[XB_XSUB(b.x)], 1u);
        const unsigned gen = old / nloc;
        if (old + 1u == (gen + 1u) * nloc) {
            __builtin_amdgcn_fence(__ATOMIC_RELEASE, "agent");
            asm volatile("s_waitcnt vmcnt(0)" ::: "memory");
            const unsigned og = xb_add(&bar[XB_TOP], 1u);
            const unsigned tg = og / nx;
            if (og + 1u == (tg + 1u) * nx) xb_add(&bar[XB_TOPGEN], 1u);
            else XB_SPIN(xb_ld(&bar[XB_TOPGEN]) == tg, bar);
            __builtin_amdgcn_fence(__ATOMIC_ACQUIRE, "agent");
            xb_add(&bar[XB_XGEN(b.x)], 1u);
            asm volatile("s_waitcnt vmcnt(0)" ::: "memory");
        } else {
            XB_SPIN(xb_ld(&bar[XB_XGEN(b.x)]) == gen, bar);
            __builtin_amdgcn_fence(__ATOMIC_ACQUIRE, "agent");
            asm volatile("s_waitcnt vmcnt(0)" ::: "memory");
        }
    }
    __syncthreads();
}

__device__ __forceinline__ void xcd_barrier_local(const XcdBarrier& b) {
    asm volatile("s_waitcnt vmcnt(0)" ::: "memory");
    __syncthreads();
    if (threadIdx.x == 0) {
        unsigned* bar = b.bar;
        __builtin_amdgcn_s_waitcnt(0);
        unsigned nloc = b.st[0], nx = b.st[1];
        if (nloc == 0u) { xcd_barrier_complete(bar, b.x, nloc, nx); b.st[0] = nloc; b.st[1] = nx; }
        const unsigned old = xb_add(&bar[XB_XSUB(b.x)], 1u);
        const unsigned gen = old / nloc;
        __builtin_amdgcn_fence(__ATOMIC_ACQUIRE, "agent");
        if (old + 1u == (gen + 1u) * nloc) xb_add(&bar[XB_XGEN(b.x)], 1u);
        else XB_SPIN(xb_ld(&bar[XB_XGEN(b.x)]) == gen, bar);
        asm volatile("s_waitcnt vmcnt(0)" ::: "memory");
    }
    __syncthreads();
}

struct KvOrder { int G, c;
    __device__ __forceinline__ bool next(int i, pg8::Unit& u) const { const int x = c + i * G; if (x >= 256) return false; u.pm = x >> 4; u.pn = x & 15; return true; }
    __device__ __forceinline__ void a_ready(const pg8::Unit&) const {}
    __device__ __forceinline__ void done(const pg8::Unit&) const {}
};

constexpr int NWAVES = 8, NTHREADS = NWAVES * 64;
constexpr int BATCH = 16, SEQ = 2048, D = 2048, M = BATCH * SEQ, DEPTH = 4;
constexpr int DFF = 5632, NFFIN = 2 * DFF, NMIX = 14336, NMEM = 256, MMEM = BATCH * NMEM;
constexpr float EPS = 1e-6f;
constexpr float LOG2E = 1.4426950408889634f;
constexpr float QSCALE_DIFF = 0.125f * LOG2E;
constexpr float QSCALE_MEM = 0.08838834764831845f * LOG2E;

constexpr size_t MiB = (size_t)1 << 20;
constexpr size_t WS_CTL = 0;
constexpr size_t ZERO_BYTES = 1 * MiB;
constexpr size_t WS_W = 8 * MiB;
constexpr size_t W_F1IN = 0, W_F1OUT = 44 * MiB, W_F2IN = 66 * MiB, W_F2OUT = 110 * MiB, W_MIXIN = 132 * MiB, W_BR3 = 188 * MiB, W_MO = 200 * MiB, W_XQ = 208 * MiB, W_XO = 210 * MiB, W_BYTES = 212 * MiB;
static_assert((size_t)NFFIN * D * 2 == 44 * MiB && (size_t)D * DFF * 2 == 22 * MiB && (size_t)NMIX * D * 2 == 56 * MiB, "weight sizes");
constexpr size_t WS_WXKV = WS_W + W_BYTES;
constexpr size_t WS_H = WS_WXKV + 16 * MiB;
constexpr size_t WS_HB = WS_H + 256 * MiB;
constexpr size_t WS_MEMB = WS_HB + 128 * MiB;
constexpr size_t WS_KVX = WS_MEMB + 16 * MiB;
constexpr size_t WS_QX = WS_KVX + 32 * MiB;
constexpr size_t WS_ACT = WS_QX + 32 * MiB;
constexpr size_t WS_QUC = WS_ACT;
constexpr size_t WS_KV2 = WS_ACT + 192 * MiB;
constexpr size_t WS_GVZ = WS_ACT + 320 * MiB;
constexpr size_t WS_GATES = WS_ACT + 448 * MiB;
constexpr size_t WS_HID = WS_GATES; constexpr int HID_SLOTS = 96;
constexpr size_t WS_RP = WS_ACT + 832 * MiB;
constexpr size_t WS_RPGV = WS_RP + 68 * MiB;
constexpr size_t WS_RPMEM = WS_RPGV + 8 * MiB;
constexpr size_t WS_W1 = WS_RPMEM + 1 * MiB;
constexpr size_t WS_END = WS_W1 + W_BYTES;
static_assert((size_t)M * DFF * 2 <= 832 * MiB, "hid fits");
constexpr int YP = 3072;

constexpr int RING_OFF = 0, RING_BYTES = 131072;
constexpr int LDSCTL_OFF = RING_BYTES, MISC_OFF = LDSCTL_OFF + 320;
constexpr int LDS_BYTES = 147456;
constexpr int RSTAB_OFF = LDSCTL_OFF + 1024;

typedef float f32x16 __attribute__((ext_vector_type(16)));
typedef unsigned u32x2 __attribute__((ext_vector_type(2)));
typedef short v4i16_t __attribute__((ext_vector_type(4)));
typedef float f32x2_t __attribute__((ext_vector_type(2)));
typedef __bf16 bf16x2_t __attribute__((ext_vector_type(2)));

__device__ __forceinline__ int opaque_tid() { int t = threadIdx.x; asm volatile("" : "+v"(t)); return t; }
#define EP_LANE() do { int l_; asm volatile("v_mbcnt_lo_u32_b32 %0, -1, 0\n\tv_mbcnt_hi_u32_b32 %0, -1, %0" : "=v"(l_)); fr = l_ & 15; fq = l_ >> 4; } while (0)
#define WG_BAR() do { asm volatile("s_waitcnt lgkmcnt(0)" ::: "memory"); __builtin_amdgcn_s_barrier(); asm volatile("" ::: "memory"); } while (0)

__device__ __forceinline__ unsigned cvtpk(float lo, float hi) { f32x2_t v = {lo, hi}; bf16x2_t b = __builtin_convertvector(v, bf16x2_t); return __builtin_bit_cast(unsigned, b); }
__device__ __forceinline__ float bflo(unsigned w) { return __uint_as_float(w << 16); }
__device__ __forceinline__ float bfhi(unsigned w) { return __uint_as_float(w & 0xffff0000u); }
__device__ __forceinline__ float ex2(float x) { return __builtin_amdgcn_exp2f(x); }
__device__ __forceinline__ float rcpf_(float x) { return __builtin_amdgcn_rcpf(x); }
__device__ __forceinline__ float rsqf_(float x) { return __builtin_amdgcn_rsqf(x); }
__device__ __forceinline__ float sigmoid_(float x) { return rcpf_(1.0f + ex2(-LOG2E * x)); }
template <int MASK> __device__ __forceinline__ float xor_lane(float v) {
    return __uint_as_float((unsigned)__builtin_amdgcn_ds_swizzle((int)__float_as_uint(v), 0x001F | (MASK << 10)));
}
__device__ __forceinline__ float half_sum(float v) { auto rr = __builtin_amdgcn_permlane32_swap(__float_as_uint(v), __float_as_uint(v), false, false); return __uint_as_float(rr[0]) + __uint_as_float(rr[1]); }
__device__ __forceinline__ float half_max(float v) { auto rr = __builtin_amdgcn_permlane32_swap(__float_as_uint(v), __float_as_uint(v), false, false); return fmaxf(__uint_as_float(rr[0]), __uint_as_float(rr[1])); }
__device__ __forceinline__ float wave_sum(float v) {
    v += xor_lane<1>(v); v += xor_lane<2>(v); v += xor_lane<4>(v); v += xor_lane<8>(v); v += xor_lane<16>(v);
    return half_sum(v);
}

namespace ep {
using pg8::f32x4; using pg8::Unit; using pg8::BM; using pg8::HALF; using pg8::bf16_t; using pg8::u32x4; using pg8::f32x2; using pg8::gelu_pk;

struct RsPart { f32x4 a, b, c, d; };
__device__ __forceinline__ void rs_issue(RsPart& P, const float* rp, int pm, int wr, int wc, int fr, int fq) {
    const int tid = (wr * 4 + wc) * 64 + fq * 16 + fr, row = tid >> 1, half = tid & 1;
    const f32x4* p = (const f32x4*)(rp + ((size_t)(pm * BM + row)) * 32 + half * 16);
    P.a = p[0]; P.b = p[1]; P.c = p[2]; P.d = p[3];
}
__device__ __forceinline__ void rs_commit(const RsPart& P, LAS float* tab, int wr, int wc, int fr, int fq) {
    const int tid = (wr * 4 + wc) * 64 + fq * 16 + fr, row = tid >> 1, half = tid & 1;
    float s = (((P.a[0] + P.a[1]) + (P.a[2] + P.a[3])) + ((P.b[0] + P.b[1]) + (P.b[2] + P.b[3]))) + (((P.c[0] + P.c[1]) + (P.c[2] + P.c[3])) + ((P.d[0] + P.d[1]) + (P.d[2] + P.d[3])));
    s += xor_lane<1>(s);
    if (half == 0) tab[row] = rsqf_(s * (1.0f / D) + EPS);
}
__device__ __forceinline__ void rs_read(float (&rs)[2][4], const LAS float* tab, int wr, int fr) {
#pragma unroll
    for (int ai = 0; ai < 2; ++ai)
#pragma unroll
        for (int m = 0; m < 4; ++m) rs[ai][m] = tab[ai * HALF + wr * 64 + m * 16 + fr];
}
#define EP_RS_PRIME() __device__ __forceinline__ void prime(const Unit& u, int wr, int wc, int fr, int fq) const { RsPart P; rs_issue(P, rp, u.pm, wr, wc, fr, fq); rs_commit(P, tab, wr, wc, fr, fq); }
#define EP_RS_BEGIN() RsPart P_; if (has_next) rs_issue(P_, rp, nxt.pm, wr, wc, fr, fq); float rs[2][4]; rs_read(rs, tab + (ui & 1) * 256, wr, fr)
#define EP_RS_END() do { if (has_next) rs_commit(P_, tab + ((ui + 1) & 1) * 256, wr, wc, fr, fq); } while (0)
__device__ __forceinline__ f32x4 gelu4(f32x4 v) { const f32x2 a = gelu_pk((f32x2){v[0], v[1]}), b = gelu_pk((f32x2){v[2], v[3]}); return (f32x4){a.x, a.y, b.x, b.y}; }
__device__ __forceinline__ f32x4 sden4(f32x4 v) { return (f32x4){fminf(1.0f + ex2(v[0]), 1e30f), fminf(1.0f + ex2(v[1]), 1e30f), fminf(1.0f + ex2(v[2]), 1e30f), fminf(1.0f + ex2(v[3]), 1e30f)}; }
__device__ __forceinline__ f32x4 sigm4(f32x4 v) { return (f32x4){sigmoid_(v[0]), sigmoid_(v[1]), sigmoid_(v[2]), sigmoid_(v[3])}; }
__device__ __forceinline__ u32x4 pack8(f32x4 a, f32x4 b) { u32x4 w; w.x = cvtpk(a[0], a[1]); w.y = cvtpk(a[2], a[3]); w.z = cvtpk(b[0], b[1]); w.w = cvtpk(b[2], b[3]); return w; }

template <int ACT, bool SS>
__device__ __forceinline__ void store_act(const f32x4 (&acc)[2][2][4][2], const float (&rs)[2][4], float scale, bf16_t* O, int ldc, int row0, int col0, float* ssq, int sslot, int fq) {
#pragma unroll
    for (int ai = 0; ai < 2; ++ai)
#pragma unroll
        for (int m = 0; m < 4; ++m) {
            const int r = row0 + ai * HALF + m * 16; bf16_t* rowp = O + (size_t)r * ldc + col0; const float s = rs[ai][m] * (ACT == 2 ? -LOG2E * scale : scale); float ss = 0.f;
#pragma unroll
            for (int bj = 0; bj < 2; ++bj) {
                f32x4 v0 = acc[ai][bj][m][0] * s, v1 = acc[ai][bj][m][1] * s;
                if (ACT == 1) { v0 = gelu4(v0); v1 = gelu4(v1); }
                if (ACT == 2) { v0 = sden4(v0); v1 = sden4(v1); }
                if (SS) { ss += (v0[0] * v0[0] + v0[1] * v0[1]) + (v0[2] * v0[2] + v0[3] * v0[3]); ss += (v1[0] * v1[0] + v1[1] * v1[1]) + (v1[2] * v1[2] + v1[3] * v1[3]); }
                if (ACT == 2) __builtin_nontemporal_store(pack8(v0, v1), (u32x4*)(rowp + bj * HALF)); else *(u32x4*)(rowp + bj * HALF) = pack8(v0, v1);
            }
            if (SS) { ss += xor_lane<16>(ss); ss = half_sum(ss); if (fq == 0) ssq[(size_t)r * 16 + sslot] = ss; }
        }
}
template <int ACT, bool TILED = false>
__device__ __forceinline__ void store_pair(const f32x4 (&acc)[2][2][4][2], const float (&rs)[2][4], bf16_t* O, int ldc, int row0, int col0) {
#pragma unroll
    for (int ai = 0; ai < 2; ++ai)
#pragma unroll
        for (int m = 0; m < 4; ++m) {
            const int r = row0 + ai * HALF + m * 16; const float s = rs[ai][m];
            bf16_t* rowp = TILED ? O + ((size_t)((r >> 8) * (ldc / 64) + (col0 >> 6)) * 256 + (r & 255)) * 64 + (col0 & 63) : O + (size_t)r * ldc + col0;
            f32x4 o[2];
#pragma unroll
            for (int n = 0; n < 2; ++n) {
                f32x4 a = acc[ai][0][m][n] * s; const f32x4 b = acc[ai][1][m][n] * s;
                if (ACT == 1) a = a * sigm4(a);
                o[n] = a * b;
            }
            if (ACT == 1) __builtin_nontemporal_store(pack8(o[0], o[1]), (u32x4*)rowp); else *(u32x4*)rowp = pack8(o[0], o[1]);
        }
}

struct EpiFfnIn {
    static constexpr int A_AUX = 0; static constexpr bool A_TILED = false; static constexpr bool PERM = true, AFTER_DRAIN = false, KHOOK = false; static constexpr int KH0 = -1, KH1 = -1;
    const float* rp; LAS float* tab; bf16_t* hid;
    EP_RS_PRIME()
    __device__ __forceinline__ void operator()(const f32x4 (&acc)[2][2][4][2], const Unit& u, int wr, int wc, int fr, int fq, int ui, bool has_next, const Unit& nxt) const {
        EP_LANE(); EP_RS_BEGIN();
        const int row0 = u.pm * BM + wr * 64 + fr;
        store_pair<1, true>(acc, rs, hid, HID_SLOTS * 64, row0, u.pn * 128 + wc * 32 + 8 * fq);
        EP_RS_END();
    }
};
struct EpiScale {
    static constexpr int A_AUX = 0; static constexpr bool A_TILED = false; static constexpr bool PERM = true, AFTER_DRAIN = false, KHOOK = false; static constexpr int KH0 = -1, KH1 = -1;
    const float* rp; LAS float* tab; bf16_t* O; int ldc; float scale;
    EP_RS_PRIME()
    __device__ __forceinline__ void operator()(const f32x4 (&acc)[2][2][4][2], const Unit& u, int wr, int wc, int fr, int fq, int ui, bool has_next, const Unit& nxt) const {
        EP_LANE(); EP_RS_BEGIN();
        const int row0 = u.pm * BM + wr * 64 + fr;
        store_act<0, false>(acc, rs, scale, O, ldc, row0, u.pn * BM + wc * 32 + 8 * fq, nullptr, 0, fq);
        EP_RS_END();
    }
};
struct EpiMixIn {
    static constexpr int A_AUX = 0; static constexpr bool A_TILED = false; static constexpr bool PERM = true, AFTER_DRAIN = false, KHOOK = false; static constexpr int KH0 = -1, KH1 = -1;
    const float* rp; LAS float* tab; float* rpgv; bf16_t *quc, *kv2, *gvz, *gates;
    EP_RS_PRIME()
    __device__ __forceinline__ void operator()(const f32x4 (&acc)[2][2][4][2], const Unit& u, int wr, int wc, int fr, int fq, int ui, bool has_next, const Unit& nxt) const {
        EP_LANE(); EP_RS_BEGIN();
        const int row0 = u.pm * BM + wr * 64 + fr;
        const int pn = u.pn, cw = wc * 32 + 8 * fq; const size_t PL = (size_t)M * 1024;
        if (pn < 4)        store_act<0, false>(acc, rs, QSCALE_DIFF, quc, YP, row0, pn * 256 + cw, nullptr, 0, fq);
        else if (pn < 8)   store_act<0, false>(acc, rs, 1.0f, kv2, 1024, row0, (pn - 4) * 256 + cw, nullptr, 0, fq);
        else if (pn < 12)  store_act<0, false>(acc, rs, 1.0f, kv2 + PL, 1024, row0, (pn - 8) * 256 + cw, nullptr, 0, fq);
        else if (pn < 16)  store_act<1, false>(acc, rs, 1.0f, quc, YP, row0, 1024 + (pn - 12) * 256 + cw, nullptr, 0, fq);
        else if (pn < 20)  store_act<1, true>(acc, rs, 1.0f, gvz, 1024, row0, (pn - 16) * 256 + cw, rpgv, (pn - 16) * 4 + wc, fq);
        else if (pn < 24)  store_act<0, false>(acc, rs, 1.0f, quc, YP, row0, 2048 + (pn - 20) * 256 + cw, nullptr, 0, fq);
        else if (pn < 32)  store_pair<0>(acc, rs, gvz + PL, 1024, row0, (pn - 24) * 128 + cw);
        else { const int gi = (pn - 32) >> 3, ct = (pn - 32) & 7;
               store_act<2, false>(acc, rs, 1.0f, gates + ((size_t)((u.pm * 8 + ct) * 3 + gi) - (size_t)u.pm) * 65536, 256, row0, cw, nullptr, 0, fq); }
        EP_RS_END();
    }
};
template <bool A_TILED_> struct EpiResidT {
    static constexpr int A_AUX = 0; static constexpr bool A_TILED = A_TILED_; static constexpr bool PERM = true, AFTER_DRAIN = false, KHOOK = false; static constexpr int KH0 = -1, KH1 = -1;
    bf16_t* hb; float* rp_next; float alpha;
    __device__ __forceinline__ void prime(const Unit&, int, int, int, int) const {}
    __device__ __forceinline__ void operator()(const f32x4 (&acc)[2][2][4][2], const Unit& u, int wr, int wc, int fr, int fq, int, bool, const Unit&) const {
        EP_LANE();
        const int row0 = u.pm * BM + wr * 64 + fr, col0 = u.pn * BM + wc * 32 + 8 * fq;
        u32x4 hv[2][4][2];
#pragma unroll
        for (int ai = 0; ai < 2; ++ai)
#pragma unroll
            for (int m = 0; m < 4; ++m)
#pragma unroll
                for (int bj = 0; bj < 2; ++bj) hv[ai][m][bj] = *(const u32x4*)(hb + (size_t)(row0 + ai * HALF + m * 16) * D + col0 + bj * HALF);
#pragma unroll
        for (int ai = 0; ai < 2; ++ai)
#pragma unroll
            for (int m = 0; m < 4; ++m) {
                const int r = row0 + ai * HALF + m * 16; const size_t off = (size_t)r * D + col0; float ss = 0.f;
#pragma unroll
                for (int bj = 0; bj < 2; ++bj) {
                    const u32x4 h4 = hv[ai][m][bj];
                    const f32x4 o0 = (f32x4){bflo(h4.x), bfhi(h4.x), bflo(h4.y), bfhi(h4.y)} + acc[ai][bj][m][0] * alpha;
                    const f32x4 o1 = (f32x4){bflo(h4.z), bfhi(h4.z), bflo(h4.w), bfhi(h4.w)} + acc[ai][bj][m][1] * alpha;
                    *(u32x4*)(hb + off + bj * HALF) = pack8(o0, o1);
                    ss += (o0[0] * o0[0] + o0[1] * o0[1]) + (o0[2] * o0[2] + o0[3] * o0[3]);
                    ss += (o1[0] * o1[0] + o1[1] * o1[1]) + (o1[2] * o1[2] + o1[3] * o1[3]);
                }
                ss += xor_lane<16>(ss); ss = half_sum(ss);
                if (fq == 0) rp_next[(size_t)r * 32 + u.pn * 4 + wc] = ss;
            }
    }
};
using EpiResid = EpiResidT<false>; using EpiResidNT = EpiResidT<true>;
struct EpiMerge {
    static constexpr int A_AUX = 0; static constexpr bool A_TILED = false; static constexpr bool PERM = true, AFTER_DRAIN = false, KHOOK = true; static constexpr int KH0 = 16, KH1 = 32;
    const bf16_t* gates; bf16_t* merged;
    __device__ __forceinline__ void prime(const Unit&, int, int, int, int) const {}
    static __device__ __forceinline__ f32x4 ratio4(unsigned n0, unsigned n1, unsigned d0, unsigned d1) {
        return (f32x4){bflo(n0) * rcpf_(fmaxf(bflo(d0), 1e-30f)), bfhi(n0) * rcpf_(fmaxf(bfhi(d0), 1e-30f)), bflo(n1) * rcpf_(fmaxf(bflo(d1), 1e-30f)), bfhi(n1) * rcpf_(fmaxf(bfhi(d1), 1e-30f))}; }
    __device__ __forceinline__ void khook(f32x4 (&acc)[2][2][4][2], const Unit& u, int t, int wr, int wc, int fr, int fq) const {
        const int br = (t >> 4) - 1;
        EP_LANE(); const int fr_ = fr, fq_ = fq;
        const int row0 = u.pm * BM + wr * 64 + fr_, col0 = u.pn * BM + wc * 32 + 8 * fq_;
        const bf16_t* gn = gates + ((size_t)(u.pm * 8 + u.pn) * 3 + br) * 65536 + (wc * 32 + 8 * fq_);
#pragma unroll
        for (int ai = 0; ai < 2; ++ai) {
            u32x4 vn[4][2], vd[4][2];
#pragma unroll
            for (int m = 0; m < 4; ++m)
#pragma unroll
                for (int bj = 0; bj < 2; ++bj) { const bf16_t* gp = gn + (wr * 64 + fr_ + ai * HALF + m * 16) * 256 + bj * HALF; vn[m][bj] = *(const u32x4*)(gp + 65536); vd[m][bj] = *(const u32x4*)gp; }
#pragma unroll
            for (int m = 0; m < 4; ++m)
#pragma unroll
                for (int bj = 0; bj < 2; ++bj) { const u32x4 a = vn[m][bj], d = vd[m][bj];
                    acc[ai][bj][m][0] = acc[ai][bj][m][0] * ratio4(a.x, a.y, d.x, d.y);
                    acc[ai][bj][m][1] = acc[ai][bj][m][1] * ratio4(a.z, a.w, d.z, d.w); }
            asm volatile("" ::: "memory");
        }
    }
    __device__ __forceinline__ void operator()(const f32x4 (&acc)[2][2][4][2], const Unit& u, int wr, int wc, int fr, int fq, int, bool, const Unit&) const {
        EP_LANE();
        const int row0 = u.pm * BM + wr * 64 + fr, col0 = u.pn * BM + wc * 32 + 8 * fq;
        u32x4 g2[2][4][2];
#pragma unroll
        for (int ai = 0; ai < 2; ++ai)
#pragma unroll
            for (int m = 0; m < 4; ++m)
#pragma unroll
                for (int bj = 0; bj < 2; ++bj) g2[ai][m][bj] = *(const u32x4*)(gates + ((size_t)(u.pm * 8 + u.pn) * 3 + 2) * 65536 + (wr * 64 + fr + ai * HALF + m * 16) * 256 + wc * 32 + 8 * fq + bj * HALF);
#pragma unroll
        for (int ai = 0; ai < 2; ++ai)
#pragma unroll
            for (int m = 0; m < 4; ++m)
#pragma unroll
                for (int bj = 0; bj < 2; ++bj) { const u32x4 gw = g2[ai][m][bj];
                    const f32x4 v0 = acc[ai][bj][m][0] * (f32x4){rcpf_(bflo(gw.x)), rcpf_(bfhi(gw.x)), rcpf_(bflo(gw.y)), rcpf_(bfhi(gw.y))};
                    const f32x4 v1 = acc[ai][bj][m][1] * (f32x4){rcpf_(bflo(gw.z)), rcpf_(bfhi(gw.z)), rcpf_(bflo(gw.w)), rcpf_(bfhi(gw.w))};
                    { const int r_ = row0 + ai * HALF + m * 16, c_ = col0 + bj * HALF;
                      *(u32x4*)(merged + ((size_t)((r_ >> 8) * (D / 64) + (c_ >> 6)) * 256 + (r_ & 255)) * 64 + (c_ & 63)) = pack8(v0, v1); } }
    }
};
}

template <int DQK, bool CAUSAL>
__device__ __forceinline__ void attn_pass(f32x16 (&o)[4], const bf16* qrow, const bf16* kbase, size_t ldk, const bf16* vbase, size_t ldv,
                                          int ntiles, int qpos, int wq_min, int wq_max, float slope2, LAS unsigned char* lds) {
    constexpr int PK = (DQK + 8) * 2, KBYTES = 64 * PK, NKS = DQK / 16, KCH = DQK / 64, CPK = DQK / 8;
    constexpr int KROUND = (KBYTES + 1023) & ~1023, BUFB = KROUND + 16384;
    constexpr float THR = 8.0f;
    const int tid = opaque_tid(), lane = tid & 63, r = lane & 31, h = lane >> 5;
    bf16x8 qr[NKS];
#pragma unroll
    for (int ks = 0; ks < NKS; ++ks) qr[ks] = *(const bf16x8*)(qrow + 16 * ks + 8 * h);
    v4u kreg[KCH], vreg[2];
#define ATT_GLOAD(t) do { \
        _Pragma("unroll") for (int i_ = 0; i_ < KCH; ++i_) { const int c_ = tid + 512 * i_, key_ = c_ / CPK, ch_ = c_ % CPK; kreg[i_] = *(const v4u*)(kbase + (size_t)(64 * (t) + key_) * ldk + ch_ * 8); } \
        _Pragma("unroll") for (int i_ = 0; i_ < 2; ++i_) { const int c_ = tid + 512 * i_, key_ = c_ >> 4, c16_ = c_ & 15; vreg[i_] = *(const v4u*)(vbase + (size_t)(64 * (t) + key_) * ldv + c16_ * 8); } } while (0)
#define ATT_LWRITE(buf) do { LAS unsigned char* Kw_ = lds + (buf) * BUFB; LAS unsigned char* Vw_ = Kw_ + KROUND; \
        _Pragma("unroll") for (int i_ = 0; i_ < KCH; ++i_) { const int c_ = tid + 512 * i_, key_ = c_ / CPK, ch_ = c_ % CPK; *(LAS v4u*)(Kw_ + key_ * PK + ch_ * 16) = kreg[i_]; } \
        _Pragma("unroll") for (int i_ = 0; i_ < 2; ++i_) { const int c_ = tid + 512 * i_, key_ = c_ >> 4, c16_ = c_ & 15; *(LAS v4u*)(Vw_ + (c16_ >> 2) * 4096 + (key_ >> 4) * 1024 + (key_ & 15) * 64 + (c16_ & 3) * 16) = vreg[i_]; } } while (0)
    const int vb = ((lane >> 4) & 1) * 32 + (lane & 3) * 8 + (4 * h + ((lane & 15) >> 2)) * 64;
    float m_run = -1e30f, l_run = 0.f;
#pragma unroll
    for (int dt = 0; dt < 4; ++dt)
#pragma unroll
        for (int e = 0; e < 16; ++e) o[dt][e] = 0.f;
    ATT_GLOAD(0); ATT_LWRITE(0);
    if (ntiles > 1) ATT_GLOAD(1);
    WG_BAR();
    for (int t = 0; t < ntiles; ++t) {
        if (t + 1 < ntiles) { ATT_LWRITE((t + 1) & 1); if (t + 2 < ntiles) ATT_GLOAD(t + 2); }
        const bool active = !CAUSAL || (64 * t <= wq_max);
        if (active) {
            const LAS unsigned char* Ks = lds + (t & 1) * BUFB; const LAS unsigned char* Vs = Ks + KROUND;
            f32x16 s0, s1;
            if (CAUSAL) { const float b0 = slope2 * (float)(64 * t + 4 * h - qpos);
#pragma unroll
                for (int e = 0; e < 16; ++e) { const int cr = (e & 3) + 8 * (e >> 2); s0[e] = fmaf(slope2, (float)cr, b0); s1[e] = fmaf(slope2, (float)(32 + cr), b0); } }
            else {
#pragma unroll
                for (int e = 0; e < 16; ++e) { s0[e] = 0.f; s1[e] = 0.f; } }
#pragma unroll
            for (int ks = 0; ks < NKS; ++ks) {
                const bf16x8 k0 = *(const LAS bf16x8*)(Ks + r * PK + (16 * ks + 8 * h) * 2);
                const bf16x8 k1 = *(const LAS bf16x8*)(Ks + (32 + r) * PK + (16 * ks + 8 * h) * 2);
                s0 = __builtin_amdgcn_mfma_f32_32x32x16_bf16(k0, qr[ks], s0, 0, 0, 0);
                s1 = __builtin_amdgcn_mfma_f32_32x32x16_bf16(k1, qr[ks], s1, 0, 0, 0);
            }
            if (CAUSAL && (64 * t + 63 > wq_min)) { const int kb = 64 * t + 4 * h - qpos;
#pragma unroll
                for (int e = 0; e < 16; ++e) { const int cr = (e & 3) + 8 * (e >> 2); if (kb + cr > 0) s0[e] = -INFINITY; if (kb + 32 + cr > 0) s1[e] = -INFINITY; } }
            float mx = fmaxf(s0[0], s1[0]);
#pragma unroll
            for (int e = 1; e < 16; ++e) mx = fmaxf(mx, fmaxf(s0[e], s1[e]));
            mx = half_max(mx);
            const bool need = mx > m_run + THR;
            if (__any(need)) {
                const float mnew = need ? mx : m_run, alpha = ex2(m_run - mnew); m_run = mnew; l_run *= alpha;
#pragma unroll
                for (int dt = 0; dt < 4; ++dt)
#pragma unroll
                    for (int e = 0; e < 16; ++e) o[dt][e] *= alpha;
            }
            float ps = 0.f;
#pragma unroll
            for (int e = 0; e < 16; ++e) { s0[e] = ex2(s0[e] - m_run); s1[e] = ex2(s1[e] - m_run); ps += s0[e] + s1[e]; }
            l_run += ps;
            v4u pw[4];
            pw[0] = (v4u){cvtpk(s0[0], s0[1]), cvtpk(s0[2], s0[3]), cvtpk(s0[4], s0[5]), cvtpk(s0[6], s0[7])};
            pw[1] = (v4u){cvtpk(s0[8], s0[9]), cvtpk(s0[10], s0[11]), cvtpk(s0[12], s0[13]), cvtpk(s0[14], s0[15])};
            pw[2] = (v4u){cvtpk(s1[0], s1[1]), cvtpk(s1[2], s1[3]), cvtpk(s1[4], s1[5]), cvtpk(s1[6], s1[7])};
            pw[3] = (v4u){cvtpk(s1[8], s1[9]), cvtpk(s1[10], s1[11]), cvtpk(s1[12], s1[13]), cvtpk(s1[14], s1[15])};
#pragma unroll
            for (int s = 0; s < 4; ++s) {
                const bf16x8 pf = __builtin_bit_cast(bf16x8, pw[s]);
#pragma unroll
                for (int dt = 0; dt < 4; ++dt) {
                    const v4i16_t lo = __builtin_amdgcn_ds_read_tr16_b64_v4i16((LAS v4i16_t*)(Vs + vb + dt * 4096 + s * 1024));
                    const v4i16_t hi = __builtin_amdgcn_ds_read_tr16_b64_v4i16((LAS v4i16_t*)(Vs + vb + dt * 4096 + s * 1024 + 512));
                    const bf16x8 vf = (bf16x8){lo[0], lo[1], lo[2], lo[3], hi[0], hi[1], hi[2], hi[3]};
                    o[dt] = __builtin_amdgcn_mfma_f32_32x32x16_bf16(vf, pf, o[dt], 0, 0, 0);
                }
            }
        }
        WG_BAR();
    }
#undef ATT_GLOAD
#undef ATT_LWRITE
    const float lt = half_sum(l_run), inv = 1.0f / lt;
#pragma unroll
    for (int dt = 0; dt < 4; ++dt)
#pragma unroll
        for (int e = 0; e < 16; ++e) o[dt][e] *= inv;
}

__device__ __forceinline__ void diff_attn_unit(int b, int hh, int qb, bf16* q  , const bf16* k, const bf16* v, const LAS float* subln  , float lam, float one_m_lam_init, LAS unsigned char* lds) {
    const int tid = opaque_tid(), lane = tid & 63, r = lane & 31, h = lane >> 5, w = __builtin_amdgcn_readfirstlane(tid >> 6);
    const size_t rowbase = (size_t)b * SEQ; const int q0 = qb * 256, qpos = q0 + 32 * w + r;
    const float slope2 = ex2(-(float)(hh + 1)) * LOG2E;
    bf16* qrow = q + (rowbase + qpos) * YP + hh * 128;
    const bf16* kb_ = k + rowbase * 1024 + hh * 128; const bf16* vb_ = v + rowbase * 1024 + hh * 128;
    f32x16 o1[4], o2[4];
    attn_pass<64, true>(o1, qrow, kb_, 1024, vb_, 1024, 4 * (qb + 1), qpos, q0 + 32 * w, q0 + 32 * w + 31, slope2, lds);
    attn_pass<64, true>(o2, qrow + 64, kb_ + 64, 1024, vb_, 1024, 4 * (qb + 1), qpos, q0 + 32 * w, q0 + 32 * w + 31, slope2, lds);
    float ss = 0.f;
#pragma unroll
    for (int dt = 0; dt < 4; ++dt)
#pragma unroll
        for (int e = 0; e < 16; ++e) { const float d = o1[dt][e] - lam * o2[dt][e]; o1[dt][e] = d; ss += d * d; }
    ss = half_sum(ss);
    const float sc = rsqf_(ss * (1.0f / 128.0f) + EPS) * one_m_lam_init;
#pragma unroll
    for (int dt = 0; dt < 4; ++dt)
#pragma unroll
        for (int pq = 0; pq < 2; ++pq) {
            float m8[8];
#pragma unroll
            for (int e = 0; e < 4; ++e) { auto rr = __builtin_amdgcn_permlane32_swap(__float_as_uint(o1[dt][8 * pq + e]), __float_as_uint(o1[dt][8 * pq + 4 + e]), false, false);
                m8[e] = __uint_as_float(rr[0]) * sc; m8[4 + e] = __uint_as_float(rr[1]) * sc; }
            const int dv = 32 * dt + 16 * pq + 8 * h; const f32x4 g0 = *(const LAS f32x4*)(subln + dv), g1 = *(const LAS f32x4*)(subln + dv + 4);
            v4u wv; wv.x = cvtpk(m8[0] * g0[0], m8[1] * g0[1]); wv.y = cvtpk(m8[2] * g0[2], m8[3] * g0[3]); wv.z = cvtpk(m8[4] * g1[0], m8[5] * g1[1]); wv.w = cvtpk(m8[6] * g1[2], m8[7] * g1[3]);
            *(v4u*)(qrow + dv) = wv;
        }
}
__device__ __forceinline__ void mem_attn_unit(int b, int hh, int qb, bf16* qx, const bf16* kvx  , LAS unsigned char* lds) {
    const int tid = opaque_tid(), lane = tid & 63, r = lane & 31, h = lane >> 5, w = __builtin_amdgcn_readfirstlane(tid >> 6);
    const size_t row = (size_t)b * SEQ + qb * 256 + 32 * w + r;
    bf16* qrow = qx + row * 512 + hh * 128;
    const bf16* kb_ = kvx + (size_t)b * NMEM * 4096 + hh * 128; const bf16* vb_ = kb_ + 512;
    f32x16 o[4];
    attn_pass<128, false>(o, qrow, kb_, 4096, vb_, 4096, NMEM / 64, 0, 0, 0, 0.f, lds);
#pragma unroll
    for (int dt = 0; dt < 4; ++dt)
#pragma unroll
        for (int pq = 0; pq < 2; ++pq) {
            float m8[8];
#pragma unroll
            for (int e = 0; e < 4; ++e) { auto rr = __builtin_amdgcn_permlane32_swap(__float_as_uint(o[dt][8 * pq + e]), __float_as_uint(o[dt][8 * pq + 4 + e]), false, false);
                m8[e] = __uint_as_float(rr[0]); m8[4 + e] = __uint_as_float(rr[1]); }
            const int dv = 32 * dt + 16 * pq + 8 * h;
            v4u wv; wv.x = cvtpk(m8[0], m8[1]); wv.y = cvtpk(m8[2], m8[3]); wv.z = cvtpk(m8[4], m8[5]); wv.w = cvtpk(m8[6], m8[7]);
            *(v4u*)(qrow + dv) = wv;
        }
}

__device__ __forceinline__ void sgu_run(int g, int p0, int n, bf16* u  , const bf16* gv  , const float* rpgv  , const float* ws  , const float* sb  , const float* snorm  , LAS unsigned char* lds) {
    const int tid = opaque_tid(), lane = tid & 63, r = lane & 31, h = lane >> 5, w = __builtin_amdgcn_readfirstlane(tid >> 6);
    const int db = w & 3, th = w >> 2, c0 = g * 128;
    const int ab = db * 8192 + (8 * h + ((lane & 15) >> 2)) * 64 + (16 * ((lane >> 4) & 1) + 4 * (lane & 3)) * 2;
    const int nks = 4 * th + 4;
    v4u bfr[2][8];
#pragma unroll
    for (int i = 0; i < 2; ++i) {
        f32x4 wl[8][2];
#pragma unroll
        for (int ks = 0; ks < 8; ++ks) { const float* wp = ws + ((size_t)(g * 128 + 32 * (2 * th + i) + r)) * 128 + 16 * ks + 8 * h; wl[ks][0] = *(const f32x4*)wp; wl[ks][1] = *(const f32x4*)(wp + 4); }
#pragma unroll
        for (int ks = 0; ks < 8; ++ks) { const int t = 32 * (2 * th + i) + r, s0 = 16 * ks + 8 * h; f32x4 w0 = wl[ks][0], w1 = wl[ks][1];
#pragma unroll
            for (int jj = 0; jj < 4; ++jj) { if (s0 + jj > t) w0[jj] = 0.f; if (s0 + 4 + jj > t) w1[jj] = 0.f; }
            bfr[i][ks] = (v4u){cvtpk(w0[0], w0[1]), cvtpk(w0[2], w0[3]), cvtpk(w1[0], w1[1]), cvtpk(w1[2], w1[3])}; }
    }
    LAS float* tabs = (LAS float*)(lds + 2 * 33280);
    if (tid < 128) tabs[tid] = snorm[c0 + tid]; else if (tid < 256) tabs[tid] = sb[g * 128 + tid - 128];
    v4u ga[4], gb[4]; f32x4 pa, pb; v4u uw[2][2], un[2][2];
#define SGU_LOAD(gr, pr, p) do { const size_t t0_ = (size_t)(p) * 128; \
        _Pragma("unroll") for (int i_ = 0; i_ < 4; ++i_) { const int c_ = tid + 512 * i_, s_ = c_ >> 4, c16_ = c_ & 15; gr[i_] = *(const v4u*)(gv + (t0_ + s_) * 1024 + c0 + c16_ * 8); } \
        pr = *(const f32x4*)(rpgv + (t0_ + (tid >> 2)) * 16 + (tid & 3) * 4); } while (0)
#define SGU_LOADU(dst, p) do { const size_t t0_ = (size_t)(p) * 128; \
        _Pragma("unroll") for (int i_ = 0; i_ < 2; ++i_) _Pragma("unroll") for (int q_ = 0; q_ < 2; ++q_) dst[i_][q_] = *(const v4u*)(u + (t0_ + 32 * (2 * th + i_) + r) * YP + c0 + 32 * db + 16 * q_ + 8 * h); } while (0)
#define SGU_WRITE(gr, pr, buf) do { LAS unsigned char* Gw_ = lds + (buf) * 33280; LAS float* rw_ = (LAS float*)(Gw_ + 32768); \
        _Pragma("unroll") for (int i_ = 0; i_ < 4; ++i_) { const int c_ = tid + 512 * i_, s_ = c_ >> 4, c16_ = c_ & 15; *(LAS v4u*)(Gw_ + (c16_ >> 2) * 8192 + (s_ >> 4) * 1024 + (s_ & 15) * 64 + (c16_ & 3) * 16) = gr[i_]; } \
        { float sq_ = (pr[0] + pr[1]) + (pr[2] + pr[3]); sq_ += xor_lane<1>(sq_); sq_ += xor_lane<2>(sq_); if ((tid & 3) == 0) rw_[tid >> 2] = rsqf_(sq_ * (1.0f / 1024.0f) + EPS); } } while (0)
    auto body = [&](int j, v4u (&gl)[4], f32x4& pl, v4u (&gw)[4], f32x4& pw) {
        const size_t t0 = (size_t)(p0 + j) * 128;
        const LAS unsigned char* Gs = lds + (j & 1) * 33280; const LAS float* rstd = (const LAS float*)(Gs + 32768);
        SGU_LOAD(gl, pl, p0 + min(j + 2, n - 1));
        SGU_LOADU(un, p0 + min(j + 1, n - 1));
        f32x16 acc[2];
#pragma unroll
        for (int i = 0; i < 2; ++i)
#pragma unroll
            for (int e = 0; e < 16; ++e) acc[i][e] = 0.f;
#pragma unroll
        for (int ks = 0; ks < 8; ++ks) {
            if (ks < nks) {
                const u32x2 lo = __builtin_bit_cast(u32x2, __builtin_amdgcn_ds_read_tr16_b64_v4i16((LAS v4i16_t*)(Gs + ab + ks * 1024)));
                const u32x2 hi = __builtin_bit_cast(u32x2, __builtin_amdgcn_ds_read_tr16_b64_v4i16((LAS v4i16_t*)(Gs + ab + ks * 1024 + 256)));
                const int s0 = 16 * ks + 8 * h;
                const f32x4 r0 = *(const LAS f32x4*)(rstd + s0), r1 = *(const LAS f32x4*)(rstd + s0 + 4);
                const v4u aw = (v4u){cvtpk(bflo(lo.x) * r0[0], bfhi(lo.x) * r0[1]), cvtpk(bflo(lo.y) * r0[2], bfhi(lo.y) * r0[3]), cvtpk(bflo(hi.x) * r1[0], bfhi(hi.x) * r1[1]), cvtpk(bflo(hi.y) * r1[2], bfhi(hi.y) * r1[3])};
                const bf16x8 af = __builtin_bit_cast(bf16x8, aw);
#pragma unroll
                for (int i = 0; i < 2; ++i)
                    if (ks < 2 * (2 * th + i + 1)) acc[i] = __builtin_amdgcn_mfma_f32_32x32x16_bf16(af, __builtin_bit_cast(bf16x8, bfr[i][ks]), acc[i], 0, 0, 0);
            }
        }
#pragma unroll
        for (int i = 0; i < 2; ++i) {
            const int t = 32 * (2 * th + i) + r; bf16* urow = u + (t0 + t) * YP + c0; const float bias = tabs[128 + t];
#pragma unroll
            for (int pq = 0; pq < 2; ++pq) {
                float m8[8];
#pragma unroll
                for (int e = 0; e < 4; ++e) { auto rr = __builtin_amdgcn_permlane32_swap(__float_as_uint(acc[i][8 * pq + e]), __float_as_uint(acc[i][8 * pq + 4 + e]), false, false);
                    m8[e] = __uint_as_float(rr[0]); m8[4 + e] = __uint_as_float(rr[1]); }
                const int d = 32 * db + 16 * pq + 8 * h; const f32x4 s0 = *(const LAS f32x4*)(tabs + d), s1 = *(const LAS f32x4*)(tabs + d + 4);
                const v4u uq = uw[i][pq]; v4u yw;
                yw.x = cvtpk(bflo(uq.x) * (m8[0] * s0[0] + bias), bfhi(uq.x) * (m8[1] * s0[1] + bias));
                yw.y = cvtpk(bflo(uq.y) * (m8[2] * s0[2] + bias), bfhi(uq.y) * (m8[3] * s0[3] + bias));
                yw.z = cvtpk(bflo(uq.z) * (m8[4] * s1[0] + bias), bfhi(uq.z) * (m8[5] * s1[1] + bias));
                yw.w = cvtpk(bflo(uq.w) * (m8[6] * s1[2] + bias), bfhi(uq.w) * (m8[7] * s1[3] + bias));
                *(v4u*)(urow + d) = yw;
            }
        }
        SGU_WRITE(gw, pw, (j + 1) & 1);
#pragma unroll
        for (int i = 0; i < 2; ++i)
#pragma unroll
            for (int pq = 0; pq < 2; ++pq) uw[i][pq] = un[i][pq];
        WG_BAR();
    };
    SGU_LOAD(ga, pa, p0); SGU_LOADU(uw, p0); SGU_LOAD(gb, pb, p0 + min(1, n - 1));
    SGU_WRITE(ga, pa, 0);
    WG_BAR();
    for (int j = 0; j < n; j += 2) { body(j, ga, pa, gb, pb); if (j + 1 < n) body(j + 1, gb, pb, ga, pa); }
#undef SGU_LOAD
#undef SGU_LOADU
#undef SGU_WRITE
}

__device__ __forceinline__ void conv_unit(int ub, bf16* cb  , const bf16* z  , const float* cw  ) {
    const int tid = opaque_tid(), cc = tid & 127, rsub = tid >> 7; const int rbeg = ub * 64 + rsub * 16;
    float w0[8], w1[8], w2[8];
#pragma unroll
    for (int j = 0; j < 2; ++j) { const f32x4 a = *(const f32x4*)(cw + cc * 8 + 4 * j), b_ = *(const f32x4*)(cw + 1024 + cc * 8 + 4 * j), c = *(const f32x4*)(cw + 2048 + cc * 8 + 4 * j);
#pragma unroll
        for (int e = 0; e < 4; ++e) { w0[4 * j + e] = a[e]; w1[4 * j + e] = b_[e]; w2[4 * j + e] = c[e]; } }
    v4u zm2 = (v4u){0u, 0u, 0u, 0u}, zm1 = (v4u){0u, 0u, 0u, 0u};
    if ((rbeg & (SEQ - 1)) != 0) { zm2 = *(const v4u*)(z + (size_t)(rbeg - 2) * 1024 + cc * 8); zm1 = *(const v4u*)(z + (size_t)(rbeg - 1) * 1024 + cc * 8); }
    v4u zr[16], cr[16];
#pragma unroll
    for (int i = 0; i < 16; ++i) { zr[i] = *(const v4u*)(z + (size_t)(rbeg + i) * 1024 + cc * 8); cr[i] = *(const v4u*)(cb + (size_t)(rbeg + i) * YP + cc * 8); }
#pragma unroll
    for (int i = 0; i < 16; ++i) {
        const v4u zc = zr[i], cv = cr[i]; v4u yo;
#pragma unroll
        for (int e = 0; e < 4; ++e) {
            const float ylo = bflo(cv[e]) * (w0[2 * e] * bflo(zm2[e]) + w1[2 * e] * bflo(zm1[e]) + w2[2 * e] * bflo(zc[e]));
            const float yhi = bfhi(cv[e]) * (w0[2 * e + 1] * bfhi(zm2[e]) + w1[2 * e + 1] * bfhi(zm1[e]) + w2[2 * e + 1] * bfhi(zc[e]));
            yo[e] = cvtpk(ylo, yhi);
        }
        *(v4u*)(cb + (size_t)(rbeg + i) * YP + cc * 8) = yo; zm2 = zm1; zm1 = zc;
    }
}

template <int MODE> __device__ __forceinline__ int dst_row(int n0, int row_off) {
    if (MODE == 1) { const int half = n0 >= DFF ? 1 : 0, jj = n0 - half * DFF; return (jj >> 7) * 256 + half * 128 + (jj & 127); }
    if (MODE == 2) { if (n0 < 6144 || n0 >= 8192) return n0; const int cc = n0 - 6144, half = cc >> 10, jj = cc & 1023; return 6144 + (jj >> 7) * 256 + half * 128 + (jj & 127); }
    return n0 + row_off;
}
__device__ __forceinline__ void tr_item(const float* W, int N, bf16* WT, int ldw, int koff, int drow0, const float* gain, LAS float* scr, int k0, int n0, int lane) {
    float v[32];
#pragma unroll
    for (int i = 0; i < 32; ++i) { const int kk = 2 * i + (lane >> 5); v[i] = W[(size_t)(k0 + kk) * N + n0 + (lane & 31)]; }
#pragma unroll
    for (int i = 0; i < 32; ++i) { const int kk = 2 * i + (lane >> 5); scr[kk * 33 + (lane & 31)] = v[i]; }
    LDS_WAIT(); asm volatile("" ::: "memory");
    const int c = lane & 7;
    f32x4 g0 = (f32x4){1.f, 1.f, 1.f, 1.f}, g1 = g0;
    if (gain) { g0 = *(const f32x4*)(gain + k0 + 8 * c); g1 = *(const f32x4*)(gain + k0 + 8 * c + 4); }
#pragma unroll
    for (int j = 0; j < 4; ++j) { const int n = (lane >> 3) + 8 * j; const LAS float* s = scr + (8 * c) * 33 + n;
        v4u o; o.x = cvtpk(s[0 * 33] * g0[0], s[1 * 33] * g0[1]); o.y = cvtpk(s[2 * 33] * g0[2], s[3 * 33] * g0[3]); o.z = cvtpk(s[4 * 33] * g1[0], s[5 * 33] * g1[1]); o.w = cvtpk(s[6 * 33] * g1[2], s[7 * 33] * g1[3]);
        *(v4u*)(WT + (size_t)(drow0 + n) * ldw + koff + k0 + 8 * c) = o; }
    LDS_WAIT(); asm volatile("" ::: "memory");
}
template <int MODE> __device__ __forceinline__ bool conv_try(int& r, const float* W, int K, int N, bf16* WT, int row_off, const float* gain, LAS float* scr, int lane, int ldw = 0, int koff = 0) {
    const int nblk = N / 32, items = (K / 64) * nblk;
    if (r >= items) { r -= items; return false; }
    const int kb = r / nblk, nb = r - kb * nblk, n0 = nb * 32;
    tr_item(W, N, WT, ldw ? ldw : K, koff, dst_row<MODE>(n0, row_off), gain, scr, kb * 64, n0, lane);
    return true;
}
__device__ __forceinline__ void row_to_bf16_ss(const float* xrow, bf16* orow, float* ss_out, int lane) {
    const f32x4* xr = (const f32x4*)xrow + lane; f32x4 v[8]; float s = 0.f;
#pragma unroll
    for (int j = 0; j < 8; ++j) { v[j] = xr[64 * j]; s += (v[j].x * v[j].x + v[j].y * v[j].y) + (v[j].z * v[j].z + v[j].w * v[j].w); }
    s = wave_sum(s);
    u32x2* o8 = (u32x2*)orow + lane;
#pragma unroll
    for (int j = 0; j < 8; ++j) { u32x2 w; w.x = cvtpk(v[j].x, v[j].y); w.y = cvtpk(v[j].z, v[j].w); o8[64 * j] = w; }
    if (lane < 32) ss_out[lane] = (lane == 0) ? s : 0.f;
}

struct Args { const float* in[26]; float* out; unsigned char* ws; int ph_lo, ph_hi; };
constexpr int PH_INIT = 0, PH_KV = 1, PH_L0 = 2, PH_PER_LAYER = 12, PH_FINAL = PH_L0 + DEPTH * PH_PER_LAYER, N_PHASES = PH_FINAL + 1;
enum { I_X = 0, I_MEM, I_F1N, I_F1WI, I_F1WO, I_MIXN, I_MIXWI, I_LAMBDA, I_SUBLN, I_DIFFWO, I_SGUN, I_SGUWS, I_SGUB, I_SGUWO, I_CONVW, I_CONVWO, I_MIXWO, I_XN, I_MEMN, I_XWQ, I_XWKV, I_XWO, I_F2N, I_F2WI, I_F2WO, I_FINALN };

__device__ __forceinline__ int opaque_s(int v) { asm volatile("" : "+s"(v)); return v; }
#define KAS __attribute__((address_space(4)))
__device__ __forceinline__ const KAS char* kargp() { const KAS char* p = (const KAS char*)__builtin_amdgcn_kernarg_segment_ptr(); asm volatile("" : "+s"(p)); return p; }
template <class T> __device__ __forceinline__ T karg(const KAS char* kp, int off) { return *(const KAS T*)(kp + off); }
constexpr int KOFF_OUT = 26 * 8, KOFF_WS = 27 * 8, KOFF_LO = 28 * 8, KOFF_HI = 28 * 8 + 4;
#define PH_ENV const KAS char* kp = kargp(); unsigned char* ws = karg<unsigned char*>(kp, KOFF_WS); (void)ws
#define KIN(i) karg<const float*>(kp, 8 * (i))
#define P_RP(k) ((float*)(ws + WS_RP) + (size_t)(k) * M * 32)
#define P_RPGV(l) ((float*)(ws + WS_RPGV) + (size_t)(l) * M * 16)
#define P_RPMEM ((float*)(ws + WS_RPMEM))
#define P_TAB ((LAS float*)(lds + RSTAB_OFF))
#define P_WL(lay, off) ((bf16*)(ws + (((lay) & 1) ? WS_W1 : WS_W) + (off)))
#define P_W(off) P_WL(l, off)
#define P_WXKV ((bf16*)(ws + WS_WXKV))
#define P_HB ((bf16*)(ws + WS_HB))
#define P_MEMB ((bf16*)(ws + WS_MEMB))
#define P_KVX ((bf16*)(ws + WS_KVX))
#define P_QX ((bf16*)(ws + WS_QX))
#define P_HID ((bf16*)(ws + WS_HID))
#define P_QUC ((bf16*)(ws + WS_QUC))
#define P_KV2 ((bf16*)(ws + WS_KV2))
#define P_GVZ ((bf16*)(ws + WS_GVZ))
#define P_GATES ((bf16*)(ws + WS_GATES))
#define P_MERGED ((bf16*)(ws + WS_H))

__global__ void __launch_bounds__(NTHREADS, 2) fwd_kernel(Args args_unused) {
    extern __shared__ __attribute__((aligned(16))) unsigned char lds_raw[];
    LAS unsigned char* lds = (LAS unsigned char*)lds_raw;
    volatile LAS unsigned* MISC = (volatile LAS unsigned*)(lds + MISC_OFF);
    const int G = gridDim.x, bx = blockIdx.x, vcu = (G % 8 == 0) ? (bx % 8) * (G / 8) + bx / 8 : bx;
    { const int tid0 = opaque_tid(); for (int u = tid0; u < (LDS_BYTES - LDSCTL_OFF) / 4; u += NTHREADS) ((LAS unsigned*)(lds + LDSCTL_OFF))[u] = 0u; }
    __syncthreads();
    int lo, hi; XcdBarrier bar;
    { PH_ENV; lo = karg<int>(kp, KOFF_LO); hi = karg<int>(kp, KOFF_HI);
      bar.bar = (unsigned*)(ws + WS_CTL) + 4096; bar.x = 0; bar.st = nullptr;
      if (hi - lo > 1) { bar = xcd_barrier_post((unsigned*)(ws + WS_CTL) + 4096, MISC + 8);
          if (threadIdx.x == 0) { unsigned* vw = (unsigned*)(ws + WS_CTL) + 9100; if (G != 256) xb_add(vw, 1u);
              __hip_atomic_fetch_max(vw + 4 + 2 * (bx & 7), bar.x + 1u, RLX_AGENT); __hip_atomic_fetch_max(vw + 5 + 2 * (bx & 7), 16u - bar.x, RLX_AGENT); } } }
#define IN(k) (lo <= (k) && (k) < hi)
#define SEAM(k) do { if (IN(k) && IN((k) + 1)) xcd_barrier(bar); } while (0)
#define SEAM_LOCAL(k) do { if (IN(k) && IN((k) + 1)) { if (MISC[15] == 1u) xcd_barrier_local(bar); else xcd_barrier(bar); } } while (0)
    constexpr size_t PL = (size_t)M * 1024;
    const int NGW = G * NWAVES;
#define WAVE_ENV const int tid = opaque_tid(), lane = tid & 63, wave = __builtin_amdgcn_readfirstlane(tid >> 6), gw = vcu * NWAVES + wave; LAS float* scr = (LAS float*)(lds + RING_OFF + wave * 16384); (void)lane; (void)gw; (void)scr

#define PREP_LAYER(l) do { \
        const float* f1wi = KIN(I_F1WI) + (size_t)(l) * D * NFFIN; const float* f1wo = KIN(I_F1WO) + (size_t)(l) * DFF * D; \
        const float* f2wi = KIN(I_F2WI) + (size_t)(l) * D * NFFIN; const float* f2wo = KIN(I_F2WO) + (size_t)(l) * DFF * D; \
        const float* mwi = KIN(I_MIXWI) + (size_t)(l) * D * NMIX; const float* dwo = KIN(I_DIFFWO) + (size_t)(l) * 1024 * D; const float* swo = KIN(I_SGUWO) + (size_t)(l) * 1024 * D; \
        const float* cwo = KIN(I_CONVWO) + (size_t)(l) * 1024 * D; const float* mwo = KIN(I_MIXWO) + (size_t)(l) * D * D; const float* xwq = KIN(I_XWQ) + (size_t)(l) * D * 512; const float* xwo = KIN(I_XWO) + (size_t)(l) * 512 * D; \
        constexpr int NIT = 2 * ((D / 64) * (NFFIN / 32) + (DFF / 64) * (D / 32)) + (D / 64) * (NMIX / 32) + 3 * (1024 / 64) * (D / 32) + (D / 64) * (D / 32) + (D / 64) * (512 / 32) + (512 / 64) * (D / 32); \
        for (int it = gw; it < NIT; it += NGW) { int r_ = it; \
            if (conv_try<1>(r_, f1wi, D, NFFIN, P_WL((l), W_F1IN), 0, KIN(I_F1N) + (l) * D, scr, lane)) continue; \
            if (conv_try<1>(r_, f2wi, D, NFFIN, P_WL((l), W_F2IN), 0, KIN(I_F2N) + (l) * D, scr, lane)) continue; \
            if (conv_try<2>(r_, mwi, D, NMIX, P_WL((l), W_MIXIN), 0, KIN(I_MIXN) + (l) * D, scr, lane)) continue; \
            if (conv_try<0>(r_, f1wo, DFF, D, P_WL((l), W_F1OUT), 0, nullptr, scr, lane)) continue; \
            if (conv_try<0>(r_, f2wo, DFF, D, P_WL((l), W_F2OUT), 0, nullptr, scr, lane)) continue; \
            if (conv_try<0>(r_, dwo, 1024, D, P_WL((l), W_BR3), 0, nullptr, scr, lane, 3072, 0)) continue; \
            if (conv_try<0>(r_, swo, 1024, D, P_WL((l), W_BR3), 0, nullptr, scr, lane, 3072, 1024)) continue; \
            if (conv_try<0>(r_, cwo, 1024, D, P_WL((l), W_BR3), 0, nullptr, scr, lane, 3072, 2048)) continue; \
            if (conv_try<0>(r_, mwo, D, D, P_WL((l), W_MO), 0, nullptr, scr, lane)) continue; \
            if (conv_try<0>(r_, xwq, D, 512, P_WL((l), W_XQ), 0, KIN(I_XN) + (l) * D, scr, lane)) continue; \
            conv_try<0>(r_, xwo, 512, D, P_WL((l), W_XO), 0, nullptr, scr, lane); } } while (0)

    if (IN(PH_INIT)) { PH_ENV; WAVE_ENV;
        for (int m = gw; m < M; m += NGW) row_to_bf16_ss(KIN(I_X) + (size_t)m * D, P_HB + (size_t)m * D, P_RP(0) + (size_t)m * 32, lane);
        for (int m = gw; m < MMEM; m += NGW) row_to_bf16_ss(KIN(I_MEM) + (size_t)m * D, P_MEMB + (size_t)m * D, P_RPMEM + (size_t)m * 32, lane);
        { constexpr int NIT = DEPTH * (D / 64) * (1024 / 32);
          for (int it = gw; it < NIT; it += NGW) { int r_ = it;
#pragma unroll
              for (int l = 0; l < DEPTH; ++l) if (conv_try<0>(r_, KIN(I_XWKV) + (size_t)l * D * 1024, D, 1024, P_WXKV, l * 1024, KIN(I_MEMN) + l * D, scr, lane)) break; } }
        { PH_ENV; WAVE_ENV; PREP_LAYER(0); }
    }
    SEAM(PH_INIT);
    if (IN(PH_INIT) && IN(PH_INIT + 1)) { PH_ENV; if (threadIdx.x == 0) { unsigned* vw = (unsigned*)(ws + WS_CTL) + 9100; bool ok = xb_ld(vw) == 0u; unsigned seen = 0u;
            for (int r8 = 0; r8 < 8; ++r8) { const unsigned mx = xb_ld(vw + 4 + 2 * r8), mn = xb_ld(vw + 5 + 2 * r8); ok = ok && mx >= 1u && (mx - 1u) == (16u - mn) && !((seen >> (mx - 1u)) & 1u); seen |= 1u << ((mx - 1u) & 15u); }
            MISC[15] = ok ? 1u : 0u; } __syncthreads(); }
    if (IN(PH_KV)) { PH_ENV;
        pg8::Gemm g{P_MEMB, P_WXKV, MMEM, 4096, D}; KvOrder S{G, opaque_s(vcu)};
        ep::EpiScale E{P_RPMEM, P_TAB, P_KVX, 4096, 1.0f};
        pg8::gemm_phase<ep::EpiScale, KvOrder, true, true>(lds + RING_OFF, g, S, E);
    }
    if (IN(PH_KV) && IN(PH_KV + 1)) { if (MISC[15] == 1u) __syncthreads(); else xcd_barrier(bar); }

    for (int l = 0; l < DEPTH; ++l) {
        const int P = PH_L0 + l * PH_PER_LAYER;
        if (l > 0) SEAM(P + 0);
        if (IN(P + 1)) { PH_ENV;
            pg8::Gemm g{P_HB, P_W(W_F1IN), M, NFFIN, D}; pg8::StaticOrder S; S.init(M, NFFIN, G, opaque_s(bx));
            ep::EpiFfnIn E{P_RP(4 * l + 0), P_TAB, P_HID};
            pg8::gemm_phase<ep::EpiFfnIn, pg8::StaticOrder, true, true>(lds + RING_OFF, g, S, E);
        }
        SEAM_LOCAL(P + 1);
        if (IN(P + 2)) { PH_ENV;
            pg8::Gemm g{P_HID, P_W(W_F1OUT), M, D, DFF, HID_SLOTS}; pg8::StaticOrder S; S.init(M, D, G, opaque_s(bx));
            ep::EpiResidNT E{P_HB, P_RP(4 * l + 1), 0.5f};
            pg8::gemm_phase<ep::EpiResidNT, pg8::StaticOrder, true, true>(lds + RING_OFF, g, S, E);
        }
        SEAM_LOCAL(P + 2);
        if (IN(P + 3)) { PH_ENV;
            pg8::Gemm g{P_HB, P_W(W_MIXIN), M, NMIX, D}; pg8::StaticOrder S; S.init(M, NMIX, G, opaque_s(bx));
            ep::EpiMixIn E{P_RP(4 * l + 1), P_TAB, P_RPGV(l), P_QUC, P_KV2, P_GVZ, P_GATES};
            pg8::gemm_phase<ep::EpiMixIn, pg8::StaticOrder, true, true>(lds + RING_OFF, g, S, E);
        }
        SEAM_LOCAL(P + 3);
        if (IN(P + 4)) { PH_ENV; WAVE_ENV;
            LAS float* lamp = (LAS float*)(lds + RING_OFF + 65536);
            const float lam_init = 0.8f - 0.6f * expf(-0.3f * (float)l);
            if (wave == 0) { const float* lp = KIN(I_LAMBDA) + l * 256; const float a = wave_sum(lp[lane] * lp[64 + lane]), b_ = wave_sum(lp[128 + lane] * lp[192 + lane]);
                if (lane == 0) lamp[0] = expf(a) - expf(b_) + lam_init; }
            WG_BAR();
            const float lam = lamp[0];
            WG_BAR();
            int bxl = bx; asm volatile("" : "+s"(bxl));
            for (int part = 0; part < 2; ++part) {
                if ((part == 0) == (((bxl >> 4) & 1) == 0)) {
            LAS float* gnl = (LAS float*)(lds + RING_OFF + 67584);
            if (tid < 128) gnl[tid] = (KIN(I_SUBLN) + l * 128)[tid];
            WG_BAR();
            for (int i = 0; i < 4; ++i) {
                for (int uu = vcu; uu < 256; uu += G) {
                    const int bh = uu >> 1, s = uu & 1; const int qb = (i == 0) ? s : (i == 1) ? 7 - s : (i == 2) ? 2 + s : 5 - s;
                    diff_attn_unit(bh >> 3, bh & 7, qb, P_QUC, P_KV2, P_KV2 + PL, gnl, lam, 1.0f - lam_init, lds + RING_OFF);
                }
            }
                } else {
            for (int uu = vcu; uu < 256; uu += G) sgu_run(uu & 7, (uu >> 3) * 8, 8, P_QUC + 1024, P_GVZ, P_RPGV(l), KIN(I_SGUWS) + (size_t)l * 8 * 128 * 128, KIN(I_SGUB) + l * 8 * 128, KIN(I_SGUN) + l * 1024, lds + RING_OFF);
            for (int uu = vcu; uu < M / 128; uu += G) { conv_unit(2 * uu, P_QUC + 2048, P_GVZ + PL, KIN(I_CONVW) + l * 3 * 1024); conv_unit(2 * uu + 1, P_QUC + 2048, P_GVZ + PL, KIN(I_CONVW) + l * 3 * 1024); }
            if (l + 1 < DEPTH) { { PH_ENV; WAVE_ENV; PREP_LAYER(l + 1); } WG_BAR(); }
                }
            }
        }
        SEAM_LOCAL(P + 4);
        if (IN(P + 5)) { PH_ENV;
            pg8::Gemm g{P_QUC, P_W(W_BR3), M, D, 3072}; pg8::StaticOrder S; S.init(M, D, G, opaque_s(bx));
            ep::EpiMerge E{P_GATES, P_MERGED};
            pg8::gemm_phase<ep::EpiMerge, pg8::StaticOrder, true, true>(lds + RING_OFF, g, S, E);
        }
        SEAM_LOCAL(P + 5);
        if (IN(P + 6)) { PH_ENV;
            pg8::Gemm g{P_MERGED, P_W(W_MO), M, D, D}; pg8::StaticOrder S; S.init(M, D, G, opaque_s(bx));
            ep::EpiResidNT E{P_HB, P_RP(4 * l + 2), 1.0f};
            pg8::gemm_phase<ep::EpiResidNT, pg8::StaticOrder, true, true>(lds + RING_OFF, g, S, E);
        }
        SEAM_LOCAL(P + 6);
        if (IN(P + 7)) { PH_ENV;
            pg8::Gemm g{P_HB, P_W(W_XQ), M, 512, D}; pg8::StaticOrder S; S.init(M, 512, G, opaque_s(bx));
            ep::EpiScale E{P_RP(4 * l + 2), P_TAB, P_QX, 512, QSCALE_MEM};
            pg8::gemm_phase<ep::EpiScale, pg8::StaticOrder, true, true>(lds + RING_OFF, g, S, E);
            pg8::Unit uq;
            for (int i = 0; S.next(i, uq); ++i)
                for (int j = 0; j < 2; ++j) mem_attn_unit(uq.pm >> 3, 2 * uq.pn + j, uq.pm & 7, P_QX, P_KVX + l * 1024, lds + RING_OFF);
        }
        SEAM_LOCAL(P + 7);
        if (IN(P + 9)) { PH_ENV;
            pg8::Gemm g{P_QX, P_W(W_XO), M, D, 512}; pg8::StaticOrder S; S.init(M, D, G, opaque_s(bx));
            ep::EpiResid E{P_HB, P_RP(4 * l + 3), 1.0f};
            pg8::gemm_phase<ep::EpiResid, pg8::StaticOrder, true, true>(lds + RING_OFF, g, S, E);
        }
        SEAM_LOCAL(P + 9);
        if (IN(P + 10)) { PH_ENV;
            pg8::Gemm g{P_HB, P_W(W_F2IN), M, NFFIN, D}; pg8::StaticOrder S; S.init(M, NFFIN, G, opaque_s(bx));
            ep::EpiFfnIn E{P_RP(4 * l + 3), P_TAB, P_HID};
            pg8::gemm_phase<ep::EpiFfnIn, pg8::StaticOrder, true, true>(lds + RING_OFF, g, S, E);
        }
        SEAM_LOCAL(P + 10);
        if (IN(P + 11)) { PH_ENV;
            pg8::Gemm g{P_HID, P_W(W_F2OUT), M, D, DFF, HID_SLOTS}; pg8::StaticOrder S; S.init(M, D, G, opaque_s(bx));
            ep::EpiResidNT E{P_HB, P_RP(4 * l + 4), 0.5f};
            pg8::gemm_phase<ep::EpiResidNT, pg8::StaticOrder, true, true>(lds + RING_OFF, g, S, E);
        }
        if (l == DEPTH - 1) SEAM_LOCAL(P + 11);
    }
    if (IN(PH_FINAL)) { PH_ENV; WAVE_ENV;
        const float* rp16 = P_RP(16); const float* gfin = KIN(I_FINALN);
        const bool xa = (G == 256); const int m0 = xa ? (vcu >> 5) * (M / 8) + (vcu & 31) * NWAVES + wave : gw, mstep = xa ? 32 * NWAVES : NGW, mend = xa ? ((vcu >> 5) + 1) * (M / 8) : M;
        for (int m = m0; m < mend; m += mstep) {
            const float ssum = wave_sum(lane < 32 ? rp16[(size_t)m * 32 + lane] : 0.f);
            const float rstd = rsqf_(ssum * (1.0f / D) + EPS);
            const u32x2* hr = (const u32x2*)(P_HB + (size_t)m * D) + lane; f32x4* orow = (f32x4*)(karg<float*>(kp, KOFF_OUT) + (size_t)m * D) + lane; const f32x4* gr = (const f32x4*)gfin + lane;
#pragma unroll
            for (int j = 0; j < 8; ++j) { const u32x2 h2 = hr[64 * j]; orow[64 * j] = (f32x4){bflo(h2.x), bfhi(h2.x), bflo(h2.y), bfhi(h2.y)} * rstd * gr[64 * j]; }
        }
    }
#undef IN
#undef SEAM
#undef SEAM_LOCAL
#undef PREP_LAYER
}

#ifndef MK_SPLIT
#define MK_SPLIT 0
#endif
extern "C" void kernel_launch(void* const* d_in, const int* in_sizes, int n_in, void* d_out, int out_size, void* d_ws, size_t ws_size, hipStream_t stream) {
    static int grid = 0;
    if (grid == 0) {
        if (n_in != 26 || out_size != M * D || ws_size < WS_END) { fprintf(stderr, "kernel_launch: unexpected shapes: n_in %d out %d ws %zu (need %zu)\n", n_in, out_size, ws_size, (size_t)WS_END); grid = -1; return; }
        int dev = 0, cus = 0, per_cu = 0;
        if (hipGetDevice(&dev) != hipSuccess || hipDeviceGetAttribute(&cus, hipDeviceAttributeMultiprocessorCount, dev) != hipSuccess) { grid = -1; return; }
        if (hipFuncSetAttribute((const void*)fwd_kernel, hipFuncAttributeMaxDynamicSharedMemorySize, LDS_BYTES) != hipSuccess) { fprintf(stderr, "kernel_launch: hipFuncSetAttribute failed\n"); grid = -1; return; }
        if (hipOccupancyMaxActiveBlocksPerMultiprocessor(&per_cu, (const void*)fwd_kernel, NTHREADS, LDS_BYTES) != hipSuccess || per_cu < 1) fprintf(stderr, "kernel_launch: occupancy query says %d\n", per_cu);
        (void)hipGetLastError();
        grid = cus;
    }
    if (grid < 0) return;
    (void)in_sizes;
    if (hipMemsetAsync((char*)d_ws, 0, ZERO_BYTES, stream) != hipSuccess) { fprintf(stderr, "kernel_launch: memset failed\n"); return; }
    Args a{};
    for (int i = 0; i < 26; ++i) a.in[i] = (const float*)d_in[i];
    a.out = (float*)d_out; a.ws = (unsigned char*)d_ws;
#if MK_SPLIT
    for (int p = 0; p < N_PHASES; ++p) { a.ph_lo = p; a.ph_hi = p + 1; hipLaunchKernelGGL(fwd_kernel, dim3(grid), dim3(NTHREADS), LDS_BYTES, stream, a); }
#else
    a.ph_lo = 0; a.ph_hi = N_PHASES;
    hipLaunchKernelGGL(fwd_kernel, dim3(grid), dim3(NTHREADS), LDS_BYTES, stream, a);
#endif
    const hipError_t le = hipPeekAtLastError();
    if (le != hipSuccess) fprintf(stderr, "kernel_launch: launch failed: %s\n", hipGetErrorName(le));
}
```

```cpp
#include <hip/hip_runtime.h>
#include <hip/hip_bf16.h>
#include <cstdio>
#include <cstdint>
#include <cmath>
namespace pg8 {
#define PG8_LAS __attribute__((address_space(3)))
typedef unsigned short bf16_t;
typedef short bf16x8 __attribute__((ext_vector_type(8)));
typedef float f32x4 __attribute__((ext_vector_type(4)));
typedef unsigned u32x4 __attribute__((ext_vector_type(4)));
constexpr int BM = 256, BK = 64, HALF = 128, HTB = HALF * BK * 2  , STAGE_BYTES = 8 * HTB, NXCD = 8, WGM = 4;

__host__ __device__ __forceinline__ int lds_byte(int r, int c) { const int st = (r >> 4) * 2 + (c >> 5), rr = r & 15, cc = c & 31, ob = rr * 64 + cc * 2; return st * 1024 + (ob ^ (((ob >> 9) & 1) << 5)); }
__host__ __device__ __forceinline__ void stage_rc(int b, int& R, int& C) { const int st = b / 1024, sb = b % 1024, swz = sb ^ (((sb >> 9) & 1) << 5); R = (st >> 1) * 16 + swz / 64; C = (st & 1) * 32 + (swz % 64) / 2; }
__host__ __device__ __forceinline__ int perm32(int rho) { const int n = rho >> 4, i = rho & 15; return 8 * (i >> 2) + 4 * n + (i & 3); }

struct Unit { int pm, pn; };
struct Gemm { const bf16_t* A; const bf16_t* Bt; int M, N, K; int a_tiles = 0; };

struct StaticOrder {
    int nM, nN, nwg, G, c;
    __host__ __device__ void init(int M, int N, int G_, int c_) { nM = M / BM; nN = N / BM; nwg = nM * nN; G = G_; c = c_; }
    __host__ __device__ __forceinline__ bool next(int i, Unit& u) const {
        const long L = (long)i * G + c; if (L >= nwg) return false;
        int wgid = (int)L; { const int q = nwg / NXCD, r = nwg % NXCD, xcd = wgid % NXCD, off = wgid / NXCD; wgid = (xcd < r ? xcd * (q + 1) : r * (q + 1) + (xcd - r) * q) + off; }
        const int nig = WGM * nN, gid = wgid / nig, fm = gid * WGM, gsz = (nM - fm) < WGM ? (nM - fm) : WGM;
        u.pm = fm + ((wgid % nig) % gsz); u.pn = (wgid % nig) / gsz; return true;
    }
    __device__ __forceinline__ void a_ready(const Unit&) const {}
    __device__ __forceinline__ void done(const Unit&) const {}
};
__device__ __forceinline__ unsigned cvt_pk_bf16(float lo, float hi) { unsigned r; asm volatile("v_cvt_pk_bf16_f32 %0, %1, %2" : "=v"(r) : "v"(lo), "v"(hi)); return r; }
typedef float f32x2 __attribute__((ext_vector_type(2)));
__device__ __forceinline__ f32x2 gelu_pk(f32x2 v) {
    const f32x2 av = __builtin_elementwise_abs(v), d = av * 0.2316418882f + 1.0f;
    f32x2 t; t.x = __builtin_amdgcn_rcpf(d.x); t.y = __builtin_amdgcn_rcpf(d.y);
    f32x2 q = t * 0.5307027145f + (-0.7265760135f); q = q * t + 0.7107068705f; q = q * t + (-0.142248368f); q = q * t + 0.127414796f; q = q * t;
    const f32x2 s = (v * v) * (-0.72134752044f);
    f32x2 e; e.x = __builtin_amdgcn_exp2f(s.x); e.y = __builtin_amdgcn_exp2f(s.y);
    const f32x2 m = v * (q * e), r = v - m;
    f32x2 o; o.x = v.x < 0.f ? m.x : r.x; o.y = v.y < 0.f ? m.y : r.y; return o;
}
template <class Epi, class Sched, bool ALIGN_EPI = false, bool SP2 = false>
__device__ __forceinline__ void gemm_phase(PG8_LAS unsigned char* lds, const Gemm g, const Sched& S, const Epi& E) {
    int tid_ = threadIdx.x; asm volatile("" : "+v"(tid_));
    const int tid = tid_, wid = __builtin_amdgcn_readfirstlane(tid >> 6), lane = tid & 63, wr = wid >> 2, wc = wid & 3, fr = lane & 15, fq = lane >> 4;
    const int K = g.K, nt = K / BK;
    unsigned voffA[2], voffB[2];
#pragma unroll
    for (int i = 0; i < 2; ++i) { int R, C; stage_rc(tid * 16 + i * 8192, R, C); const int Rb = Epi::PERM ? ((R & ~31) + perm32(R & 31)) : R;
        voffA[i] = Epi::A_TILED ? (unsigned)(R * BK + C) * 2u : (unsigned)(R * K + C) * 2u; voffB[i] = (unsigned)(Rb * K + C) * 2u; }
    const size_t kstep = (size_t)(BK * 2);
    const size_t hstep = (size_t)HALF * K * 2;
    const size_t tstep = 2 * hstep;
    const size_t kstepA = Epi::A_TILED ? (size_t)(2 * HALF * BK * 2) : kstep, hstepA = Epi::A_TILED ? (size_t)(HALF * BK * 2) : hstep, tstepA = Epi::A_TILED ? (size_t)(g.a_tiles ? g.a_tiles : nt) * kstepA : tstep;
    const unsigned ldsw = (unsigned)wid * 1024u;
    const int aoff = lds_byte(wr * 64 + fr, fq * 8), boff = lds_byte(wc * 32 + fr, fq * 8);
#define PG8_SA(b, h) (((b) * 2 + (h)) * HTB)
#define PG8_SB(b, h) ((4 + (b) * 2 + (h)) * HTB)
#define PG8_STAGE(bufoff, gbase, voff) do { _Pragma("unroll") for (int _i = 0; _i < 2; ++_i) \
        __builtin_amdgcn_global_load_lds((const unsigned*)((const char*)(gbase) + (voff)[_i]), (PG8_LAS unsigned*)(lds + (bufoff) + ldsw + _i * 8192), 16, 0, 0); } while (0)
#define PG8_STAGE_A(bufoff, gbase, voff) do { _Pragma("unroll") for (int _i = 0; _i < 2; ++_i) \
        __builtin_amdgcn_global_load_lds((const unsigned*)((const char*)(gbase) + (voff)[_i]), (PG8_LAS unsigned*)(lds + (bufoff) + ldsw + _i * 8192), 16, 0, Epi::A_AUX); } while (0)
#define PG8_LDA(dst, b, h) do { _Pragma("unroll") for (int m = 0; m < 4; ++m) _Pragma("unroll") for (int k = 0; k < 2; ++k) dst[m][k] = *(const PG8_LAS bf16x8*)(lds + PG8_SA(b, h) + aoff + m * 2048 + k * 1024); } while (0)
#define PG8_LDB(dst, b, h) do { _Pragma("unroll") for (int n = 0; n < 2; ++n) _Pragma("unroll") for (int k = 0; k < 2; ++k) dst[n][k] = *(const PG8_LAS bf16x8*)(lds + PG8_SB(b, h) + boff + n * 2048 + k * 1024); } while (0)
#define PG8_MMA(ai, bj, At, Bt) do { __builtin_amdgcn_s_setprio(1); _Pragma("unroll") for (int m = 0; m < 4; ++m) _Pragma("unroll") for (int n = 0; n < 2; ++n) _Pragma("unroll") for (int k = 0; k < 2; ++k) \
        acc[ai][bj][m][n] = __builtin_amdgcn_mfma_f32_16x16x32_bf16(Bt[n][k], At[m][k], acc[ai][bj][m][n], 0, 0, 0); __builtin_amdgcn_s_setprio(0); } while (0)
#define PG8_WAIT_V(n) asm volatile("s_waitcnt vmcnt(" #n ")" ::: "memory")
#define PG8_WAIT_L(n) asm volatile("s_waitcnt lgkmcnt(" #n ")" ::: "memory")
#define PG8_BAR __builtin_amdgcn_s_barrier()
#define PG8_SCHED __builtin_amdgcn_sched_barrier(0)
    Unit cur, nxt; int ui = 0;
    if (!S.next(0, cur)) return;
    f32x4 acc[2][2][4][2];
#pragma unroll
    for (int a = 0; a < 2; ++a)
#pragma unroll
        for (int b = 0; b < 2; ++b)
#pragma unroll
            for (int m = 0; m < 4; ++m)
#pragma unroll
                for (int n = 0; n < 2; ++n) acc[a][b][m][n] = (f32x4){0.f, 0.f, 0.f, 0.f};
    bf16x8 At[4][2], B0[2][2], B1[2][2];
    const char* cA = (const char*)g.A + (size_t)cur.pm * tstepA; const char* cB = (const char*)g.Bt + (size_t)cur.pn * tstep;
    S.a_ready(cur);
    E.prime(cur, wr, wc, fr, fq);
    if constexpr (SP2) {
        PG8_STAGE(PG8_SB(0, 0), cB, voffB); PG8_STAGE(PG8_SB(0, 1), cB + hstep, voffB); PG8_STAGE_A(PG8_SA(0, 0), cA, voffA); PG8_STAGE_A(PG8_SA(0, 1), cA + hstepA, voffA);
        if (wr == 1) PG8_BAR;
        PG8_WAIT_V(2); PG8_BAR;
        PG8_STAGE(PG8_SB(1, 0), cB + kstep, voffB); PG8_STAGE_A(PG8_SA(1, 0), cA + kstepA, voffA); PG8_STAGE(PG8_SB(1, 1), cB + hstep + kstep, voffB);
        PG8_WAIT_V(6); PG8_BAR;
    } else {
        PG8_STAGE(PG8_SB(0, 0), cB, voffB); PG8_STAGE_A(PG8_SA(0, 0), cA, voffA); PG8_STAGE(PG8_SB(0, 1), cB + hstep, voffB); PG8_STAGE_A(PG8_SA(0, 1), cA + hstepA, voffA);
        if (wr == 1) PG8_BAR;
        PG8_WAIT_V(4); PG8_BAR;
        PG8_STAGE(PG8_SB(1, 0), cB + kstep, voffB); PG8_STAGE_A(PG8_SA(1, 0), cA + kstepA, voffA); PG8_STAGE(PG8_SB(1, 1), cB + hstep + kstep, voffB);
        PG8_WAIT_V(6); PG8_BAR;
    }
    for (;;) {
        const bool has_next = S.next(ui + 1, nxt);
        const char* nA = has_next ? (const char*)g.A + (size_t)nxt.pm * tstepA : cA; const char* nB = has_next ? (const char*)g.Bt + (size_t)nxt.pn * tstep : cB;
        for (int t = 0; t < nt; t += 2) {
            const bool last = (t == nt - 2);
            const char* a1 = cA + (size_t)(t + 1) * kstepA;
            const char* a2 = last ? nA : cA + (size_t)(t + 2) * kstepA; const char* b2 = last ? nB : cB + (size_t)(t + 2) * kstep;
            const char* a3 = a2 + kstepA; const char* b3 = b2 + kstep;
            if (last && has_next) S.a_ready(nxt);
            if constexpr (Epi::KHOOK) { if (t == Epi::KH0 || t == Epi::KH1) { if (wr == 0) PG8_BAR;
                E.khook(acc, cur, t, wr, wc, fr, fq); if (wr == 1) PG8_BAR; } }
            if constexpr (SP2) {
            PG8_LDB(B0, 0, 0); PG8_LDB(B1, 0, 1); PG8_SCHED; PG8_LDA(At, 0, 0); PG8_STAGE_A(PG8_SA(1, 1), a1 + hstepA, voffA);
            PG8_WAIT_V(8); PG8_WAIT_L(0); PG8_BAR; PG8_MMA(0, 0, At, B0); PG8_MMA(0, 1, At, B1); PG8_BAR; PG8_SCHED;
            PG8_LDA(At, 0, 1); PG8_STAGE(PG8_SB(0, 0), b2, voffB); PG8_STAGE(PG8_SB(0, 1), b2 + hstep, voffB); PG8_STAGE_A(PG8_SA(0, 0), a2, voffA);
            PG8_WAIT_V(8); PG8_WAIT_L(0); PG8_BAR; PG8_MMA(1, 0, At, B0); PG8_MMA(1, 1, At, B1); PG8_BAR; PG8_SCHED;
            PG8_LDB(B0, 1, 0); PG8_LDB(B1, 1, 1); PG8_SCHED; PG8_LDA(At, 1, 0); PG8_STAGE_A(PG8_SA(0, 1), a2 + hstepA, voffA);
            PG8_WAIT_V(8); PG8_WAIT_L(0); PG8_BAR; PG8_MMA(0, 0, At, B0); PG8_MMA(0, 1, At, B1); PG8_BAR; PG8_SCHED;
            PG8_LDA(At, 1, 1); PG8_STAGE(PG8_SB(1, 0), b3, voffB); PG8_STAGE(PG8_SB(1, 1), b3 + hstep, voffB); PG8_STAGE_A(PG8_SA(1, 0), a3, voffA);
            PG8_WAIT_V(8); PG8_WAIT_L(0); PG8_BAR; PG8_MMA(1, 0, At, B0); PG8_MMA(1, 1, At, B1); PG8_BAR; PG8_SCHED;
            } else {
            PG8_LDB(B0, 0, 0); PG8_SCHED; PG8_LDA(At, 0, 0); PG8_STAGE_A(PG8_SA(1, 1), a1 + hstepA, voffA);
            PG8_WAIT_L(8); PG8_BAR; PG8_WAIT_L(0); PG8_MMA(0, 0, At, B0); PG8_BAR; PG8_SCHED;
            PG8_LDB(B1, 0, 1); PG8_STAGE(PG8_SB(0, 0), b2, voffB);
            PG8_BAR; PG8_WAIT_L(0); PG8_MMA(0, 1, At, B1); PG8_BAR;
            PG8_LDA(At, 0, 1); PG8_STAGE_A(PG8_SA(0, 0), a2, voffA);
            PG8_BAR; PG8_WAIT_L(0); PG8_MMA(1, 0, At, B0); PG8_BAR; PG8_SCHED;
            PG8_STAGE(PG8_SB(0, 1), b2 + hstep, voffB);
            PG8_WAIT_V(6); PG8_BAR; PG8_MMA(1, 1, At, B1); PG8_BAR;
            PG8_LDB(B0, 1, 0); PG8_SCHED; PG8_LDA(At, 1, 0); PG8_STAGE_A(PG8_SA(0, 1), a2 + hstepA, voffA);
            PG8_WAIT_L(8); PG8_BAR; PG8_WAIT_L(0); PG8_MMA(0, 0, At, B0); PG8_BAR; PG8_SCHED;
            PG8_LDB(B1, 1, 1); PG8_STAGE(PG8_SB(1, 0), b3, voffB);
            PG8_BAR; PG8_WAIT_L(0); PG8_MMA(0, 1, At, B1); PG8_BAR;
            PG8_LDA(At, 1, 1); PG8_STAGE_A(PG8_SA(1, 0), a3, voffA);
            PG8_BAR; PG8_WAIT_L(0); PG8_MMA(1, 0, At, B0); PG8_BAR; PG8_SCHED;
            PG8_STAGE(PG8_SB(1, 1), b3 + hstep, voffB);
            PG8_WAIT_V(6); PG8_BAR; PG8_MMA(1, 1, At, B1); PG8_BAR;
            }
        }
        if constexpr (ALIGN_EPI) { if (wr == 0) PG8_BAR; }
        if constexpr (!Epi::AFTER_DRAIN) { E(acc, cur, wr, wc, fr, fq, ui, has_next, nxt); S.done(cur); }
        if (!has_next) break;
#pragma unroll
        for (int a = 0; a < 2; ++a)
#pragma unroll
            for (int b = 0; b < 2; ++b)
#pragma unroll
                for (int m = 0; m < 4; ++m)
#pragma unroll
                    for (int n = 0; n < 2; ++n) acc[a][b][m][n] = (f32x4){0.f, 0.f, 0.f, 0.f};
        cur = nxt; cA = nA; cB = nB; ++ui;
        if constexpr (ALIGN_EPI) { if (wr == 1) PG8_BAR; }
    }
    PG8_WAIT_V(0);
    if constexpr (!ALIGN_EPI) { if (wr == 0) PG8_BAR; }
    PG8_BAR;
    if constexpr (Epi::AFTER_DRAIN) { E.fused(acc, cur, wr, wc, fr, fq, lds, wid, lane); S.done(cur); }
#undef PG8_SA
#undef PG8_SB
#undef PG8_STAGE
#undef PG8_LDA
#undef PG8_LDB
#undef PG8_MMA
#undef PG8_WAIT_V
#undef PG8_WAIT_L
#undef PG8_BAR
#undef PG8_SCHED
}
}
#define GAS __attribute__((address_space(1)))
#define LAS __attribute__((address_space(3)))
typedef unsigned short bf16;
typedef unsigned v4u __attribute__((ext_vector_type(4)));
typedef float f32x4 __attribute__((ext_vector_type(4)));
typedef short bf16x8 __attribute__((ext_vector_type(8)));
typedef GAS unsigned gu32;
typedef GAS unsigned long long gu64;
#define RLX_AGENT __ATOMIC_RELAXED, __HIP_MEMORY_SCOPE_AGENT
#define LDS_WAIT() asm volatile("s_waitcnt lgkmcnt(0)" ::: "memory")
#define VM_WAIT() asm volatile("s_waitcnt vmcnt(0)" ::: "memory")
__device__ __forceinline__ unsigned long long rt() { return __builtin_amdgcn_s_memrealtime(); }
__device__ __forceinline__ unsigned f2bf(float f) { unsigned u = __builtin_bit_cast(unsigned, f); return (u + 0x7fffu + ((u >> 16) & 1u)) >> 16; }
__device__ __forceinline__ unsigned pk2(float lo, float hi) { return f2bf(lo) | (f2bf(hi) << 16); }
#define XB_TMO      128
#define XB_XCNT(j)  (256  + 64 * (j))
#define XB_XSUB(j)  (1280 + 64 * (j))
#define XB_XGEN(j)  (2304 + 64 * (j))
#define XB_TOP      3328
#define XB_TOPGEN   3392
#define XCD_BAR_WORDS 3456
#define XB_SPIN_CAP (1u << 18)

__device__ __forceinline__ unsigned xb_ld(unsigned* p)              { return __hip_atomic_load(p, __ATOMIC_RELAXED, __HIP_MEMORY_SCOPE_AGENT); }
__device__ __forceinline__ unsigned xb_add(unsigned* p, unsigned v) { return __hip_atomic_fetch_add(p, v, __ATOMIC_RELAXED, __HIP_MEMORY_SCOPE_AGENT); }
__device__ __forceinline__ unsigned xb_xcc_id() { return (unsigned)__builtin_amdgcn_s_getreg((3 << 11) | 20) & 0xFu; }
#define XB_SPIN(cond, bar) do { unsigned _sp = 0; while (cond) { __builtin_amdgcn_s_sleep(1); \
    if ((++_sp & 255u) == 0u) { if (xb_ld(&(bar)[XB_TMO])) break; if (_sp > XB_SPIN_CAP) { atomicAdd(&(bar)[XB_TMO], 1u); break; } } } } while (0)

struct XcdBarrier {
    unsigned* bar; unsigned x;
    volatile LAS unsigned* st;
};

__device__ __forceinline__ XcdBarrier xcd_barrier_post(unsigned* bar, volatile LAS unsigned* st) {
    XcdBarrier b; b.bar = bar; b.x = xb_xcc_id(); b.st = st;
    if (threadIdx.x == 0) (void)xb_add(&bar[XB_XCNT(b.x)], 1u);
    return b;
}
__device__ __forceinline__ void xcd_barrier_complete(unsigned* bar, unsigned x, unsigned& nloc, unsigned& nx) {
    const unsigned G = gridDim.x * gridDim.y * gridDim.z;
    unsigned sum, cnt, mine, sp = 0u;
    for (;;) {
        sum = 0u; cnt = 0u; mine = 0u;
#pragma unroll
        for (unsigned j = 0; j < 16; ++j) { const unsigned c = xb_ld(&bar[XB_XCNT(j)]); sum += c; cnt += (c > 0u) ? 1u : 0u; mine = (j == x) ? c : mine; }
        if (sum == G) break;
        __builtin_amdgcn_s_sleep(1);
        if ((++sp & 255u) == 0u) { if (xb_ld(&bar[XB_TMO])) break; if (sp > XB_SPIN_CAP) { atomicAdd(&bar[XB_TMO], 1u); break; } }
    }
    nloc = mine > 0u ? mine : 1u; nx = cnt > 0u ? cnt : 1u;
}

__device__ __forceinline__ void xcd_barrier(const XcdBarrier& b) {
    asm volatile("s_waitcnt vmcnt(0)" ::: "memory");
    __syncthreads();
    if (threadIdx.x == 0) {
        unsigned* bar = b.bar;
        __builtin_amdgcn_s_waitcnt(0);
        unsigned nloc = b.st[0], nx = b.st[1];
        if (nloc == 0u) { xcd_barrier_complete(bar, b.x, nloc, nx); b.st[0] = nloc; b.st[1] = nx; }
        const unsigned old = xb_add(&bar[XB_XSUB(b.x)], 1u);
        const unsigned gen = old / nloc;
        if (old + 1u == (gen + 1u) * nloc) {
            __builtin_amdgcn_fence(__ATOMIC_RELEASE, "agent");
            asm volatile("s_waitcnt vmcnt(0)" ::: "memory");
            const unsigned og = xb_add(&bar[XB_TOP], 1u);
            const unsigned tg = og / nx;
            if (og + 1u == (tg + 1u) * nx) xb_add(&bar[XB_TOPGEN], 1u);
            else XB_SPIN(xb_ld(&bar[XB_TOPGEN]) == tg, bar);
            __builtin_amdgcn_fence(__ATOMIC_ACQUIRE, "agent");
            xb_add(&bar[XB_XGEN(b.x)], 1u);
            asm volatile("s_waitcnt vmcnt(0)" ::: "memory");
        } else {
            XB_SPIN(xb_ld(&bar[XB_XGEN(b.x)]) == gen, bar);
            __builtin_amdgcn_fence(__ATOMIC_ACQUIRE, "agent");
            asm volatile("s_waitcnt vmcnt(0)" ::: "memory");
        }
    }
    __syncthreads();
}

__device__ __forceinline__ void xcd_barrier_local(const XcdBarrier& b) {
    asm volatile("s_waitcnt vmcnt(0)" ::: "memory");
    __syncthreads();
    if (threadIdx.x == 0) {
        unsigned* bar = b.bar;
        __builtin_amdgcn_s_waitcnt(0);
        unsigned nloc = b.st[0], nx = b.st[1];
        if (nloc == 0u) { xcd_barrier_complete(bar, b.x, nloc, nx); b.st[0] = nloc; b.st[1] = nx; }
        const unsigned old = xb_add(&bar[XB_XSUB(b.x)], 1u);
        const unsigned gen = old / nloc;
        __builtin_amdgcn_fence(__ATOMIC_ACQUIRE, "agent");
        if (old + 1u == (gen + 1u) * nloc) xb_add(&bar[XB_XGEN(b.x)], 1u);
        else XB_SPIN(xb_ld(&bar[XB_XGEN(b.x)]) == gen, bar);
        asm volatile("s_waitcnt vmcnt(0)" ::: "memory");
    }
    __syncthreads();
}

struct KvOrder { int G, c;
    __device__ __forceinline__ bool next(int i, pg8::Unit& u) const { const int x = c + i * G; if (x >= 256) return false; u.pm = x >> 4; u.pn = x & 15; return true; }
    __device__ __forceinline__ void a_ready(const pg8::Unit&) const {}
    __device__ __forceinline__ void done(const pg8::Unit&) const {}
};

constexpr int NWAVES = 8, NTHREADS = NWAVES * 64;
constexpr int BATCH = 16, SEQ = 2048, D = 2048, M = BATCH * SEQ, DEPTH = 4;
constexpr int DFF = 5632, NFFIN = 2 * DFF, NMIX = 14336, NMEM = 256, MMEM = BATCH * NMEM;
constexpr float EPS = 1e-6f;
constexpr float LOG2E = 1.4426950408889634f;
constexpr float QSCALE_DIFF = 0.125f * LOG2E;
constexpr float QSCALE_MEM = 0.08838834764831845f * LOG2E;

constexpr size_t MiB = (size_t)1 << 20;
constexpr size_t WS_CTL = 0;
constexpr size_t ZERO_BYTES = 1 * MiB;
constexpr size_t WS_W = 8 * MiB;
constexpr size_t W_F1IN = 0, W_F1OUT = 44 * MiB, W_F2IN = 66 * MiB, W_F2OUT = 110 * MiB, W_MIXIN = 132 * MiB, W_BR3 = 188 * MiB, W_MO = 200 * MiB, W_XQ = 208 * MiB, W_XO = 210 * MiB, W_BYTES = 212 * MiB;
static_assert((size_t)NFFIN * D * 2 == 44 * MiB && (size_t)D * DFF * 2 == 22 * MiB && (size_t)NMIX * D * 2 == 56 * MiB, "weight sizes");
constexpr size_t WS_WXKV = WS_W + W_BYTES;
constexpr size_t WS_H = WS_WXKV + 16 * MiB;
constexpr size_t WS_HB = WS_H + 256 * MiB;
constexpr size_t WS_MEMB = WS_HB + 128 * MiB;
constexpr size_t WS_KVX = WS_MEMB + 16 * MiB;
constexpr size_t WS_QX = WS_KVX + 32 * MiB;
constexpr size_t WS_ACT = WS_QX + 32 * MiB;
constexpr size_t WS_QUC = WS_ACT;
constexpr size_t WS_KV2 = WS_ACT + 192 * MiB;
constexpr size_t WS_GVZ = WS_ACT + 320 * MiB;
constexpr size_t WS_GATES = WS_ACT + 448 * MiB;
constexpr size_t WS_HID = WS_GATES; constexpr int HID_SLOTS = 96;
constexpr size_t WS_RP = WS_ACT + 832 * MiB;
constexpr size_t WS_RPGV = WS_RP + 68 * MiB;
constexpr size_t WS_RPMEM = WS_RPGV + 8 * MiB;
constexpr size_t WS_W1 = WS_RPMEM + 1 * MiB;
constexpr size_t WS_END = WS_W1 + W_BYTES;
static_assert((size_t)M * DFF * 2 <= 832 * MiB, "hid fits");
constexpr int YP = 3072;

constexpr int RING_OFF = 0, RING_BYTES = 131072;
constexpr int LDSCTL_OFF = RING_BYTES, MISC_OFF = LDSCTL_OFF + 320;
constexpr int LDS_BYTES = 147456;
constexpr int RSTAB_OFF = LDSCTL_OFF + 1024;

typedef float f32x16 __attribute__((ext_vector_type(16)));
typedef unsigned u32x2 __attribute__((ext_vector_type(2)));
typedef short v4i16_t __attribute__((ext_vector_type(4)));
typedef float f32x2_t __attribute__((ext_vector_type(2)));
typedef __bf16 bf16x2_t __attribute__((ext_vector_type(2)));

__device__ __forceinline__ int opaque_tid() { int t = threadIdx.x; asm volatile("" : "+v"(t)); return t; }
#define EP_LANE() do { int l_; asm volatile("v_mbcnt_lo_u32_b32 %0, -1, 0\n\tv_mbcnt_hi_u32_b32 %0, -1, %0" : "=v"(l_)); fr = l_ & 15; fq = l_ >> 4; } while (0)
#define WG_BAR() do { asm volatile("s_waitcnt lgkmcnt(0)" ::: "memory"); __builtin_amdgcn_s_barrier(); asm volatile("" ::: "memory"); } while (0)

__device__ __forceinline__ unsigned cvtpk(float lo, float hi) { f32x2_t v = {lo, hi}; bf16x2_t b = __builtin_convertvector(v, bf16x2_t); return __builtin_bit_cast(unsigned, b); }
__device__ __forceinline__ float bflo(unsigned w) { return __uint_as_float(w << 16); }
__device__ __forceinline__ float bfhi(unsigned w) { return __uint_as_float(w & 0xffff0000u); }
__device__ __forceinline__ float ex2(float x) { return __builtin_amdgcn_exp2f(x); }
__device__ __forceinline__ float rcpf_(float x) { return __builtin_amdgcn_rcpf(x); }
__device__ __forceinline__ float rsqf_(float x) { return __builtin_amdgcn_rsqf(x); }
__device__ __forceinline__ float sigmoid_(float x) { return rcpf_(1.0f + ex2(-LOG2E * x)); }
template <int MASK> __device__ __forceinline__ float xor_lane(float v) {
    return __uint_as_float((unsigned)__builtin_amdgcn_ds_swizzle((int)__float_as_uint(v), 0x001F | (MASK << 10)));
}
__device__ __forceinline__ float half_sum(float v) { auto rr = __builtin_amdgcn_permlane32_swap(__float_as_uint(v), __float_as_uint(v), false, false); return __uint_as_float(rr[0]) + __uint_as_float(rr[1]); }
__device__ __forceinline__ float half_max(float v) { auto rr = __builtin_amdgcn_permlane32_swap(__float_as_uint(v), __float_as_uint(v), false, false); return fmaxf(__uint_as_float(rr[0]), __uint_as_float(rr[1])); }
__device__ __forceinline__ float wave_sum(float v) {
    v += xor_lane<1>(v); v += xor_lane<2>(v); v += xor_lane<4>(v); v += xor_lane<8>(v); v += xor_lane<16>(v);
    return half_sum(v);
}

namespace ep {
using pg8::f32x4; using pg8::Unit; using pg8::BM; using pg8::HALF; using pg8::bf16_t; using pg8::u32x4; using pg8::f32x2; using pg8::gelu_pk;

struct RsPart { f32x4 a, b, c, d; };
__device__ __forceinline__ void rs_issue(RsPart& P, const float* rp, int pm, int wr, int wc, int fr, int fq) {
    const int tid = (wr * 4 + wc) * 64 + fq * 16 + fr, row = tid >> 1, half = tid & 1;
    const f32x4* p = (const f32x4*)(rp + ((size_t)(pm * BM + row)) * 32 + half * 16);
    P.a = p[0]; P.b = p[1]; P.c = p[2]; P.d = p[3];
}
__device__ __forceinline__ void rs_commit(const RsPart& P, LAS float* tab, int wr, int wc, int fr, int fq) {
    const int tid = (wr * 4 + wc) * 64 + fq * 16 + fr, row = tid >> 1, half = tid & 1;
    float s = (((P.a[0] + P.a[1]) + (P.a[2] + P.a[3])) + ((P.b[0] + P.b[1]) + (P.b[2] + P.b[3]))) + (((P.c[0] + P.c[1]) + (P.c[2] + P.c[3])) + ((P.d[0] + P.d[1]) + (P.d[2] + P.d[3])));
    s += xor_lane<1>(s);
    if (half == 0) tab[row] = rsqf_(s * (1.0f / D) + EPS);
}
__device__ __forceinline__ void rs_read(float (&rs)[2][4], const LAS float* tab, int wr, int fr) {
#pragma unroll
    for (int ai = 0; ai < 2; ++ai)
#pragma unroll
        for (int m = 0; m < 4; ++m) rs[ai][m] = tab[ai * HALF + wr * 64 + m * 16 + fr];
}
#define EP_RS_PRIME() __device__ __forceinline__ void prime(const Unit& u, int wr, int wc, int fr, int fq) const { RsPart P; rs_issue(P, rp, u.pm, wr, wc, fr, fq); rs_commit(P, tab, wr, wc, fr, fq); }
#define EP_RS_BEGIN() RsPart P_; if (has_next) rs_issue(P_, rp, nxt.pm, wr, wc, fr, fq); float rs[2][4]; rs_read(rs, tab + (ui & 1) * 256, wr, fr)
#define EP_RS_END() do { if (has_next) rs_commit(P_, tab + ((ui + 1) & 1) * 256, wr, wc, fr, fq); } while (0)
__device__ __forceinline__ f32x4 gelu4(f32x4 v) { const f32x2 a = gelu_pk((f32x2){v[0], v[1]}), b = gelu_pk((f32x2){v[2], v[3]}); return (f32x4){a.x, a.y, b.x, b.y}; }
__device__ __forceinline__ f32x4 sigm4(f32x4 v) { return (f32x4){sigmoid_(v[0]), sigmoid_(v[1]), sigmoid_(v[2]), sigmoid_(v[3])}; }
__device__ __forceinline__ u32x4 pack8(f32x4 a, f32x4 b) { u32x4 w; w.x = cvtpk(a[0], a[1]); w.y = cvtpk(a[2], a[3]); w.z = cvtpk(b[0], b[1]); w.w = cvtpk(b[2], b[3]); return w; }

template <int ACT, bool SS>
__device__ __forceinline__ void store_act(const f32x4 (&acc)[2][2][4][2], const float (&rs)[2][4], float scale, bf16_t* O, int ldc, int row0, int col0, float* ssq, int sslot, int fq) {
#pragma unroll
    for (int ai = 0; ai < 2; ++ai)
#pragma unroll
        for (int m = 0; m < 4; ++m) {
            const int r = row0 + ai * HALF + m * 16; bf16_t* rowp = O + (size_t)r * ldc + col0; const float s = rs[ai][m] * scale; float ss = 0.f;
#pragma unroll
            for (int bj = 0; bj < 2; ++bj) {
                f32x4 v0 = acc[ai][bj][m][0] * s, v1 = acc[ai][bj][m][1] * s;
                if (ACT == 1) { v0 = gelu4(v0); v1 = gelu4(v1); }
                if (ACT == 2) { v0 = sigm4(v0); v1 = sigm4(v1); }
                if (SS) { ss += (v0[0] * v0[0] + v0[1] * v0[1]) + (v0[2] * v0[2] + v0[3] * v0[3]); ss += (v1[0] * v1[0] + v1[1] * v1[1]) + (v1[2] * v1[2] + v1[3] * v1[3]); }
                if (ACT == 2) __builtin_nontemporal_store(pack8(v0, v1), (u32x4*)(rowp + bj * HALF)); else *(u32x4*)(rowp + bj * HALF) = pack8(v0, v1);
            }
            if (SS) { ss += xor_lane<16>(ss); ss = half_sum(ss); if (fq == 0) ssq[(size_t)r * 16 + sslot] = ss; }
        }
}
template <int ACT, bool TILED = false>
__device__ __forceinline__ void store_pair(const f32x4 (&acc)[2][2][4][2], const float (&rs)[2][4], bf16_t* O, int ldc, int row0, int col0) {
#pragma unroll
    for (int ai = 0; ai < 2; ++ai)
#pragma unroll
        for (int m = 0; m < 4; ++m) {
            const int r = row0 + ai * HALF + m * 16; const float s = rs[ai][m];
            bf16_t* rowp = TILED ? O + ((size_t)((r >> 8) * (ldc / 64) + (col0 >> 6)) * 256 + (r & 255)) * 64 + (col0 & 63) : O + (size_t)r * ldc + col0;
            f32x4 o[2];
#pragma unroll
            for (int n = 0; n < 2; ++n) {
                f32x4 a = acc[ai][0][m][n] * s; const f32x4 b = acc[ai][1][m][n] * s;
                if (ACT == 1) a = a * sigm4(a);
                o[n] = a * b;
            }
            if (ACT == 1) __builtin_nontemporal_store(pack8(o[0], o[1]), (u32x4*)rowp); else *(u32x4*)rowp = pack8(o[0], o[1]);
        }
}

struct EpiFfnIn {
    static constexpr int A_AUX = 0; static constexpr bool A_TILED = false; static constexpr bool PERM = true, AFTER_DRAIN = false, KHOOK = false; static constexpr int KH0 = -1, KH1 = -1;
    const float* rp; LAS float* tab; bf16_t* hid;
    EP_RS_PRIME()
    __device__ __forceinline__ void operator()(const f32x4 (&acc)[2][2][4][2], const Unit& u, int wr, int wc, int fr, int fq, int ui, bool has_next, const Unit& nxt) const {
        EP_LANE(); EP_RS_BEGIN();
        const int row0 = u.pm * BM + wr * 64 + fr;
        store_pair<1, true>(acc, rs, hid, HID_SLOTS * 64, row0, u.pn * 128 + wc * 32 + 8 * fq);
        EP_RS_END();
    }
};
struct EpiScale {
    static constexpr int A_AUX = 0; static constexpr bool A_TILED = false; static constexpr bool PERM = true, AFTER_DRAIN = false, KHOOK = false; static constexpr int KH0 = -1, KH1 = -1;
    const float* rp; LAS float* tab; bf16_t* O; int ldc; float scale;
    EP_RS_PRIME()
    __device__ __forceinline__ void operator()(const f32x4 (&acc)[2][2][4][2], const Unit& u, int wr, int wc, int fr, int fq, int ui, bool has_next, const Unit& nxt) const {
        EP_LANE(); EP_RS_BEGIN();
        const int row0 = u.pm * BM + wr * 64 + fr;
        store_act<0, false>(acc, rs, scale, O, ldc, row0, u.pn * BM + wc * 32 + 8 * fq, nullptr, 0, fq);
        EP_RS_END();
    }
};
struct EpiMixIn {
    static constexpr int A_AUX = 0; static constexpr bool A_TILED = false; static constexpr bool PERM = true, AFTER_DRAIN = false, KHOOK = false; static constexpr int KH0 = -1, KH1 = -1;
    const float* rp; LAS float* tab; float* rpgv; bf16_t *quc, *kv2, *gvz, *gates;
    EP_RS_PRIME()
    __device__ __forceinline__ void operator()(const f32x4 (&acc)[2][2][4][2], const Unit& u, int wr, int wc, int fr, int fq, int ui, bool has_next, const Unit& nxt) const {
        EP_LANE(); EP_RS_BEGIN();
        const int row0 = u.pm * BM + wr * 64 + fr;
        const int pn = u.pn, cw = wc * 32 + 8 * fq; const size_t PL = (size_t)M * 1024;
        if (pn < 4)        store_act<0, false>(acc, rs, QSCALE_DIFF, quc, YP, row0, pn * 256 + cw, nullptr, 0, fq);
        else if (pn < 8)   store_act<0, false>(acc, rs, 1.0f, kv2, 1024, row0, (pn - 4) * 256 + cw, nullptr, 0, fq);
        else if (pn < 12)  store_act<0, false>(acc, rs, 1.0f, kv2 + PL, 1024, row0, (pn - 8) * 256 + cw, nullptr, 0, fq);
        else if (pn < 16)  store_act<1, false>(acc, rs, 1.0f, quc, YP, row0, 1024 + (pn - 12) * 256 + cw, nullptr, 0, fq);
        else if (pn < 20)  store_act<1, true>(acc, rs, 1.0f, gvz, 1024, row0, (pn - 16) * 256 + cw, rpgv, (pn - 16) * 4 + wc, fq);
        else if (pn < 24)  store_act<0, false>(acc, rs, 1.0f, quc, YP, row0, 2048 + (pn - 20) * 256 + cw, nullptr, 0, fq);
        else if (pn < 32)  store_pair<0>(acc, rs, gvz + PL, 1024, row0, (pn - 24) * 128 + cw);
        else { const int gi = (pn - 32) >> 3, ct = (pn - 32) & 7;
               store_act<2, false>(acc, rs, 1.0f, gates + ((size_t)((u.pm * 8 + ct) * 3 + gi) - (size_t)u.pm) * 65536, 256, row0, cw, nullptr, 0, fq); }
        EP_RS_END();
    }
};
template <bool A_TILED_> struct EpiResidT {
    static constexpr int A_AUX = 0; static constexpr bool A_TILED = A_TILED_; static constexpr bool PERM = true, AFTER_DRAIN = false, KHOOK = false; static constexpr int KH0 = -1, KH1 = -1;
    bf16_t* hb; float* rp_next; float alpha;
    __device__ __forceinline__ void prime(const Unit&, int, int, int, int) const {}
    __device__ __forceinline__ void operator()(const f32x4 (&acc)[2][2][4][2], const Unit& u, int wr, int wc, int fr, int fq, int, bool, const Unit&) const {
        EP_LANE();
        const int row0 = u.pm * BM + wr * 64 + fr, col0 = u.pn * BM + wc * 32 + 8 * fq;
        u32x4 hv[2][4][2];
#pragma unroll
        for (int ai = 0; ai < 2; ++ai)
#pragma unroll
            for (int m = 0; m < 4; ++m)
#pragma unroll
                for (int bj = 0; bj < 2; ++bj) hv[ai][m][bj] = *(const u32x4*)(hb + (size_t)(row0 + ai * HALF + m * 16) * D + col0 + bj * HALF);
#pragma unroll
        for (int ai = 0; ai < 2; ++ai)
#pragma unroll
            for (int m = 0; m < 4; ++m) {
                const int r = row0 + ai * HALF + m * 16; const size_t off = (size_t)r * D + col0; float ss = 0.f;
#pragma unroll
                for (int bj = 0; bj < 2; ++bj) {
                    const u32x4 h4 = hv[ai][m][bj];
                    const f32x4 o0 = (f32x4){bflo(h4.x), bfhi(h4.x), bflo(h4.y), bfhi(h4.y)} + acc[ai][bj][m][0] * alpha;
                    const f32x4 o1 = (f32x4){bflo(h4.z), bfhi(h4.z), bflo(h4.w), bfhi(h4.w)} + acc[ai][bj][m][1] * alpha;
                    *(u32x4*)(hb + off + bj * HALF) = pack8(o0, o1);
                    ss += (o0[0] * o0[0] + o0[1] * o0[1]) + (o0[2] * o0[2] + o0[3] * o0[3]);
                    ss += (o1[0] * o1[0] + o1[1] * o1[1]) + (o1[2] * o1[2] + o1[3] * o1[3]);
                }
                ss += xor_lane<16>(ss); ss = half_sum(ss);
                if (fq == 0) rp_next[(size_t)r * 32 + u.pn * 4 + wc] = ss;
            }
    }
};
using EpiResid = EpiResidT<false>; using EpiResidNT = EpiResidT<true>;
struct EpiMerge {
    static constexpr int A_AUX = 0; static constexpr bool A_TILED = false; static constexpr bool PERM = true, AFTER_DRAIN = false, KHOOK = true; static constexpr int KH0 = 16, KH1 = 32;
    const bf16_t* gates; bf16_t* merged;
    __device__ __forceinline__ void prime(const Unit&, int, int, int, int) const {}
    static __device__ __forceinline__ f32x4 ratio4(unsigned n0, unsigned n1, unsigned d0, unsigned d1) {
        return (f32x4){bflo(n0) * rcpf_(fmaxf(bflo(d0), 1e-30f)), bfhi(n0) * rcpf_(fmaxf(bfhi(d0), 1e-30f)), bflo(n1) * rcpf_(fmaxf(bflo(d1), 1e-30f)), bfhi(n1) * rcpf_(fmaxf(bfhi(d1), 1e-30f))}; }
    __device__ __forceinline__ void khook(f32x4 (&acc)[2][2][4][2], const Unit& u, int t, int wr, int wc, int fr, int fq) const {
        const int br = (t >> 4) - 1;
        EP_LANE(); const int fr_ = fr, fq_ = fq;
        const int row0 = u.pm * BM + wr * 64 + fr_, col0 = u.pn * BM + wc * 32 + 8 * fq_;
        const bf16_t* gn = gates + ((size_t)(u.pm * 8 + u.pn) * 3 + br) * 65536 + (wc * 32 + 8 * fq_);
#pragma unroll
        for (int ai = 0; ai < 2; ++ai) {
            u32x4 vn[4][2], vd[4][2];
#pragma unroll
            for (int m = 0; m < 4; ++m)
#pragma unroll
                for (int bj = 0; bj < 2; ++bj) { const bf16_t* gp = gn + (wr * 64 + fr_ + ai * HALF + m * 16) * 256 + bj * HALF; vn[m][bj] = *(const u32x4*)gp; vd[m][bj] = *(const u32x4*)(gp + 65536); }
#pragma unroll
            for (int m = 0; m < 4; ++m)
#pragma unroll
                for (int bj = 0; bj < 2; ++bj) { const u32x4 a = vn[m][bj], d = vd[m][bj];
                    acc[ai][bj][m][0] = acc[ai][bj][m][0] * ratio4(a.x, a.y, d.x, d.y);
                    acc[ai][bj][m][1] = acc[ai][bj][m][1] * ratio4(a.z, a.w, d.z, d.w); }
            asm volatile("" ::: "memory");
        }
    }
    __device__ __forceinline__ void operator()(const f32x4 (&acc)[2][2][4][2], const Unit& u, int wr, int wc, int fr, int fq, int, bool, const Unit&) const {
        EP_LANE();
        const int row0 = u.pm * BM + wr * 64 + fr, col0 = u.pn * BM + wc * 32 + 8 * fq;
        u32x4 g2[2][4][2];
#pragma unroll
        for (int ai = 0; ai < 2; ++ai)
#pragma unroll
            for (int m = 0; m < 4; ++m)
#pragma unroll
                for (int bj = 0; bj < 2; ++bj) g2[ai][m][bj] = *(const u32x4*)(gates + ((size_t)(u.pm * 8 + u.pn) * 3 + 2) * 65536 + (wr * 64 + fr + ai * HALF + m * 16) * 256 + wc * 32 + 8 * fq + bj * HALF);
#pragma unroll
        for (int ai = 0; ai < 2; ++ai)
#pragma unroll
            for (int m = 0; m < 4; ++m)
#pragma unroll
                for (int bj = 0; bj < 2; ++bj) { const u32x4 gw = g2[ai][m][bj];
                    const f32x4 v0 = acc[ai][bj][m][0] * (f32x4){bflo(gw.x), bfhi(gw.x), bflo(gw.y), bfhi(gw.y)};
                    const f32x4 v1 = acc[ai][bj][m][1] * (f32x4){bflo(gw.z), bfhi(gw.z), bflo(gw.w), bfhi(gw.w)};
                    { const int r_ = row0 + ai * HALF + m * 16, c_ = col0 + bj * HALF;
                      *(u32x4*)(merged + ((size_t)((r_ >> 8) * (D / 64) + (c_ >> 6)) * 256 + (r_ & 255)) * 64 + (c_ & 63)) = pack8(v0, v1); } }
    }
};
}

template <int DQK, bool CAUSAL>
__device__ __forceinline__ void attn_pass(f32x16 (&o)[4], const bf16* qrow, const bf16* kbase, size_t ldk, const bf16* vbase, size_t ldv,
                                          int ntiles, int qpos, int wq_min, int wq_max, float slope2, LAS unsigned char* lds) {
    constexpr int PK = (DQK + 8) * 2, KBYTES = 64 * PK, NKS = DQK / 16, KCH = DQK / 64, CPK = DQK / 8;
    constexpr int KROUND = (KBYTES + 1023) & ~1023, BUFB = KROUND + 16384;
    constexpr float THR = 8.0f;
    const int tid = opaque_tid(), lane = tid & 63, r = lane & 31, h = lane >> 5;
    bf16x8 qr[NKS];
#pragma unroll
    for (int ks = 0; ks < NKS; ++ks) qr[ks] = *(const bf16x8*)(qrow + 16 * ks + 8 * h);
    v4u kreg[KCH], vreg[2];
#define ATT_GLOAD(t) do { \
        _Pragma("unroll") for (int i_ = 0; i_ < KCH; ++i_) { const int c_ = tid + 512 * i_, key_ = c_ / CPK, ch_ = c_ % CPK; kreg[i_] = *(const v4u*)(kbase + (size_t)(64 * (t) + key_) * ldk + ch_ * 8); } \
        _Pragma("unroll") for (int i_ = 0; i_ < 2; ++i_) { const int c_ = tid + 512 * i_, key_ = c_ >> 4, c16_ = c_ & 15; vreg[i_] = *(const v4u*)(vbase + (size_t)(64 * (t) + key_) * ldv + c16_ * 8); } } while (0)
#define ATT_LWRITE(buf) do { LAS unsigned char* Kw_ = lds + (buf) * BUFB; LAS unsigned char* Vw_ = Kw_ + KROUND; \
        _Pragma("unroll") for (int i_ = 0; i_ < KCH; ++i_) { const int c_ = tid + 512 * i_, key_ = c_ / CPK, ch_ = c_ % CPK; *(LAS v4u*)(Kw_ + key_ * PK + ch_ * 16) = kreg[i_]; } \
        _Pragma("unroll") for (int i_ = 0; i_ < 2; ++i_) { const int c_ = tid + 512 * i_, key_ = c_ >> 4, c16_ = c_ & 15; *(LAS v4u*)(Vw_ + (c16_ >> 2) * 4096 + (key_ >> 4) * 1024 + (key_ & 15) * 64 + (c16_ & 3) * 16) = vreg[i_]; } } while (0)
    const int vb = ((lane >> 4) & 1) * 32 + (lane & 3) * 8 + (4 * h + ((lane & 15) >> 2)) * 64;
    float m_run = -1e30f, l_run = 0.f;
#pragma unroll
    for (int dt = 0; dt < 4; ++dt)
#pragma unroll
        for (int e = 0; e < 16; ++e) o[dt][e] = 0.f;
    ATT_GLOAD(0); ATT_LWRITE(0);
    if (ntiles > 1) ATT_GLOAD(1);
    WG_BAR();
    for (int t = 0; t < ntiles; ++t) {
        if (t + 1 < ntiles) { ATT_LWRITE((t + 1) & 1); if (t + 2 < ntiles) ATT_GLOAD(t + 2); }
        const bool active = !CAUSAL || (64 * t <= wq_max);
        if (active) {
            const LAS unsigned char* Ks = lds + (t & 1) * BUFB; const LAS unsigned char* Vs = Ks + KROUND;
            f32x16 s0, s1;
            if (CAUSAL) { const float b0 = slope2 * (float)(64 * t + 4 * h - qpos);
#pragma unroll
                for (int e = 0; e < 16; ++e) { const int cr = (e & 3) + 8 * (e >> 2); s0[e] = fmaf(slope2, (float)cr, b0); s1[e] = fmaf(slope2, (float)(32 + cr), b0); } }
            else {
#pragma unroll
                for (int e = 0; e < 16; ++e) { s0[e] = 0.f; s1[e] = 0.f; } }
#pragma unroll
            for (int ks = 0; ks < NKS; ++ks) {
                const bf16x8 k0 = *(const LAS bf16x8*)(Ks + r * PK + (16 * ks + 8 * h) * 2);
                const bf16x8 k1 = *(const LAS bf16x8*)(Ks + (32 + r) * PK + (16 * ks + 8 * h) * 2);
                s0 = __builtin_amdgcn_mfma_f32_32x32x16_bf16(k0, qr[ks], s0, 0, 0, 0);
                s1 = __builtin_amdgcn_mfma_f32_32x32x16_bf16(k1, qr[ks], s1, 0, 0, 0);
            }
            if (CAUSAL && (64 * t + 63 > wq_min)) { const int kb = 64 * t + 4 * h - qpos;
#pragma unroll
                for (int e = 0; e < 16; ++e) { const int cr = (e & 3) + 8 * (e >> 2); if (kb + cr > 0) s0[e] = -INFINITY; if (kb + 32 + cr > 0) s1[e] = -INFINITY; } }
            float mx = fmaxf(s0[0], s1[0]);
#pragma unroll
            for (int e = 1; e < 16; ++e) mx = fmaxf(mx, fmaxf(s0[e], s1[e]));
            mx = half_max(mx);
            const bool need = mx > m_run + THR;
            if (__any(need)) {
                const float mnew = need ? mx : m_run, alpha = ex2(m_run - mnew); m_run = mnew; l_run *= alpha;
#pragma unroll
                for (int dt = 0; dt < 4; ++dt)
#pragma unroll
                    for (int e = 0; e < 16; ++e) o[dt][e] *= alpha;
            }
            float ps = 0.f;
#pragma unroll
            for (int e = 0; e < 16; ++e) { s0[e] = ex2(s0[e] - m_run); s1[e] = ex2(s1[e] - m_run); ps += s0[e] + s1[e]; }
            l_run += ps;
            v4u pw[4];
            pw[0] = (v4u){cvtpk(s0[0], s0[1]), cvtpk(s0[2], s0[3]), cvtpk(s0[4], s0[5]), cvtpk(s0[6], s0[7])};
            pw[1] = (v4u){cvtpk(s0[8], s0[9]), cvtpk(s0[10], s0[11]), cvtpk(s0[12], s0[13]), cvtpk(s0[14], s0[15])};
            pw[2] = (v4u){cvtpk(s1[0], s1[1]), cvtpk(s1[2], s1[3]), cvtpk(s1[4], s1[5]), cvtpk(s1[6], s1[7])};
            pw[3] = (v4u){cvtpk(s1[8], s1[9]), cvtpk(s1[10], s1[11]), cvtpk(s1[12], s1[13]), cvtpk(s1[14], s1[15])};
#pragma unroll
            for (int s = 0; s < 4; ++s) {
                const bf16x8 pf = __builtin_bit_cast(bf16x8, pw[s]);
#pragma unroll
                for (int dt = 0; dt < 4; ++dt) {
                    const v4i16_t lo = __builtin_amdgcn_ds_read_tr16_b64_v4i16((LAS v4i16_t*)(Vs + vb + dt * 4096 + s * 1024));
                    const v4i16_t hi = __builtin_amdgcn_ds_read_tr16_b64_v4i16((LAS v4i16_t*)(Vs + vb + dt * 4096 + s * 1024 + 512));
                    const bf16x8 vf = (bf16x8){lo[0], lo[1], lo[2], lo[3], hi[0], hi[1], hi[2], hi[3]};
                    o[dt] = __builtin_amdgcn_mfma_f32_32x32x16_bf16(vf, pf, o[dt], 0, 0, 0);
                }
            }
        }
        WG_BAR();
    }
#undef ATT_GLOAD
#undef ATT_LWRITE
    const float lt = half_sum(l_run), inv = 1.0f / lt;
#pragma unroll
    for (int dt = 0; dt < 4; ++dt)
#pragma unroll
        for (int e = 0; e < 16; ++e) o[dt][e] *= inv;
}

__device__ __forceinline__ void diff_attn_unit(int b, int hh, int qb, bf16* q  , const bf16* k, const bf16* v, const LAS float* subln  , float lam, float one_m_lam_init, LAS unsigned char* lds) {
    const int tid = opaque_tid(), lane = tid & 63, r = lane & 31, h = lane >> 5, w = __builtin_amdgcn_readfirstlane(tid >> 6);
    const size_t rowbase = (size_t)b * SEQ; const int q0 = qb * 256, qpos = q0 + 32 * w + r;
    const float slope2 = ex2(-(float)(hh + 1)) * LOG2E;
    bf16* qrow = q + (rowbase + qpos) * YP + hh * 128;
    const bf16* kb_ = k + rowbase * 1024 + hh * 128; const bf16* vb_ = v + rowbase * 1024 + hh * 128;
    f32x16 o1[4], o2[4];
    attn_pass<64, true>(o1, qrow, kb_, 1024, vb_, 1024, 4 * (qb + 1), qpos, q0 + 32 * w, q0 + 32 * w + 31, slope2, lds);
    attn_pass<64, true>(o2, qrow + 64, kb_ + 64, 1024, vb_, 1024, 4 * (qb + 1), qpos, q0 + 32 * w, q0 + 32 * w + 31, slope2, lds);
    float ss = 0.f;
#pragma unroll
    for (int dt = 0; dt < 4; ++dt)
#pragma unroll
        for (int e = 0; e < 16; ++e) { const float d = o1[dt][e] - lam * o2[dt][e]; o1[dt][e] = d; ss += d * d; }
    ss = half_sum(ss);
    const float sc = rsqf_(ss * (1.0f / 128.0f) + EPS) * one_m_lam_init;
#pragma unroll
    for (int dt = 0; dt < 4; ++dt)
#pragma unroll
        for (int pq = 0; pq < 2; ++pq) {
            float m8[8];
#pragma unroll
            for (int e = 0; e < 4; ++e) { auto rr = __builtin_amdgcn_permlane32_swap(__float_as_uint(o1[dt][8 * pq + e]), __float_as_uint(o1[dt][8 * pq + 4 + e]), false, false);
                m8[e] = __uint_as_float(rr[0]) * sc; m8[4 + e] = __uint_as_float(rr[1]) * sc; }
            const int dv = 32 * dt + 16 * pq + 8 * h; const f32x4 g0 = *(const LAS f32x4*)(subln + dv), g1 = *(const LAS f32x4*)(subln + dv + 4);
            v4u wv; wv.x = cvtpk(m8[0] * g0[0], m8[1] * g0[1]); wv.y = cvtpk(m8[2] * g0[2], m8[3] * g0[3]); wv.z = cvtpk(m8[4] * g1[0], m8[5] * g1[1]); wv.w = cvtpk(m8[6] * g1[2], m8[7] * g1[3]);
            *(v4u*)(qrow + dv) = wv;
        }
}
__device__ __forceinline__ void mem_attn_unit(int b, int hh, int qb, bf16* qx, const bf16* kvx  , LAS unsigned char* lds) {
    const int tid = opaque_tid(), lane = tid & 63, r = lane & 31, h = lane >> 5, w = __builtin_amdgcn_readfirstlane(tid >> 6);
    const size_t row = (size_t)b * SEQ + qb * 256 + 32 * w + r;
    bf16* qrow = qx + row * 512 + hh * 128;
    const bf16* kb_ = kvx + (size_t)b * NMEM * 4096 + hh * 128; const bf16* vb_ = kb_ + 512;
    f32x16 o[4];
    attn_pass<128, false>(o, qrow, kb_, 4096, vb_, 4096, NMEM / 64, 0, 0, 0, 0.f, lds);
#pragma unroll
    for (int dt = 0; dt < 4; ++dt)
#pragma unroll
        for (int g = 0; g < 4; ++g) {
            const int dv = 32 * dt + 8 * g + 4 * h;
            u32x2 wv; wv.x = cvtpk(o[dt][4 * g], o[dt][4 * g + 1]); wv.y = cvtpk(o[dt][4 * g + 2], o[dt][4 * g + 3]);
            *(u32x2*)(qrow + dv) = wv;
        }
}

__device__ __forceinline__ void sgu_run(int g, int p0, int n, bf16* u  , const bf16* gv  , const float* rpgv  , const float* ws  , const float* sb  , const float* snorm  , LAS unsigned char* lds) {
    const int tid = opaque_tid(), lane = tid & 63, r = lane & 31, h = lane >> 5, w = __builtin_amdgcn_readfirstlane(tid >> 6);
    const int db = w & 3, th = w >> 2, c0 = g * 128;
    const int ab = db * 8192 + (8 * h + ((lane & 15) >> 2)) * 64 + (16 * ((lane >> 4) & 1) + 4 * (lane & 3)) * 2;
    const int nks = 4 * th + 4;
    v4u bfr[2][8];
#pragma unroll
    for (int i = 0; i < 2; ++i) {
        f32x4 wl[8][2];
#pragma unroll
        for (int ks = 0; ks < 8; ++ks) { const float* wp = ws + ((size_t)(g * 128 + 32 * (2 * th + i) + r)) * 128 + 16 * ks + 8 * h; wl[ks][0] = *(const f32x4*)wp; wl[ks][1] = *(const f32x4*)(wp + 4); }
#pragma unroll
        for (int ks = 0; ks < 8; ++ks) { const int t = 32 * (2 * th + i) + r, s0 = 16 * ks + 8 * h; f32x4 w0 = wl[ks][0], w1 = wl[ks][1];
#pragma unroll
            for (int jj = 0; jj < 4; ++jj) { if (s0 + jj > t) w0[jj] = 0.f; if (s0 + 4 + jj > t) w1[jj] = 0.f; }
            bfr[i][ks] = (v4u){cvtpk(w0[0], w0[1]), cvtpk(w0[2], w0[3]), cvtpk(w1[0], w1[1]), cvtpk(w1[2], w1[3])}; }
    }
    LAS float* tabs = (LAS float*)(lds + 2 * 33280);
    if (tid < 128) tabs[tid] = snorm[c0 + tid]; else if (tid < 256) tabs[tid] = sb[g * 128 + tid - 128];
    v4u ga[4], gb[4]; f32x4 pa, pb; v4u uw[2][2], un[2][2];
#define SGU_LOAD(gr, pr, p) do { const size_t t0_ = (size_t)(p) * 128; \
        _Pragma("unroll") for (int i_ = 0; i_ < 4; ++i_) { const int c_ = tid + 512 * i_, s_ = c_ >> 4, c16_ = c_ & 15; gr[i_] = *(const v4u*)(gv + (t0_ + s_) * 1024 + c0 + c16_ * 8); } \
        pr = *(const f32x4*)(rpgv + (t0_ + (tid >> 2)) * 16 + (tid & 3) * 4); } while (0)
#define SGU_LOADU(dst, p) do { const size_t t0_ = (size_t)(p) * 128; \
        _Pragma("unroll") for (int i_ = 0; i_ < 2; ++i_) _Pragma("unroll") for (int q_ = 0; q_ < 2; ++q_) dst[i_][q_] = *(const v4u*)(u + (t0_ + 32 * (2 * th + i_) + r) * YP + c0 + 32 * db + 16 * q_ + 8 * h); } while (0)
#define SGU_WRITE(gr, pr, buf) do { LAS unsigned char* Gw_ = lds + (buf) * 33280; LAS float* rw_ = (LAS float*)(Gw_ + 32768); \
        _Pragma("unroll") for (int i_ = 0; i_ < 4; ++i_) { const int c_ = tid + 512 * i_, s_ = c_ >> 4, c16_ = c_ & 15; *(LAS v4u*)(Gw_ + (c16_ >> 2) * 8192 + (s_ >> 4) * 1024 + (s_ & 15) * 64 + (c16_ & 3) * 16) = gr[i_]; } \
        { float sq_ = (pr[0] + pr[1]) + (pr[2] + pr[3]); sq_ += xor_lane<1>(sq_); sq_ += xor_lane<2>(sq_); if ((tid & 3) == 0) rw_[tid >> 2] = rsqf_(sq_ * (1.0f / 1024.0f) + EPS); } } while (0)
    auto body = [&](int j, v4u (&gl)[4], f32x4& pl, v4u (&gw)[4], f32x4& pw) {
        const size_t t0 = (size_t)(p0 + j) * 128;
        const LAS unsigned char* Gs = lds + (j & 1) * 33280; const LAS float* rstd = (const LAS float*)(Gs + 32768);
        SGU_LOAD(gl, pl, p0 + min(j + 2, n - 1));
        SGU_LOADU(un, p0 + min(j + 1, n - 1));
        f32x16 acc[2];
#pragma unroll
        for (int i = 0; i < 2; ++i)
#pragma unroll
            for (int e = 0; e < 16; ++e) acc[i][e] = 0.f;
#pragma unroll
        for (int ks = 0; ks < 8; ++ks) {
            if (ks < nks) {
                const u32x2 lo = __builtin_bit_cast(u32x2, __builtin_amdgcn_ds_read_tr16_b64_v4i16((LAS v4i16_t*)(Gs + ab + ks * 1024)));
                const u32x2 hi = __builtin_bit_cast(u32x2, __builtin_amdgcn_ds_read_tr16_b64_v4i16((LAS v4i16_t*)(Gs + ab + ks * 1024 + 256)));
                const int s0 = 16 * ks + 8 * h;
                const f32x4 r0 = *(const LAS f32x4*)(rstd + s0), r1 = *(const LAS f32x4*)(rstd + s0 + 4);
                const v4u aw = (v4u){cvtpk(bflo(lo.x) * r0[0], bfhi(lo.x) * r0[1]), cvtpk(bflo(lo.y) * r0[2], bfhi(lo.y) * r0[3]), cvtpk(bflo(hi.x) * r1[0], bfhi(hi.x) * r1[1]), cvtpk(bflo(hi.y) * r1[2], bfhi(hi.y) * r1[3])};
                const bf16x8 af = __builtin_bit_cast(bf16x8, aw);
#pragma unroll
                for (int i = 0; i < 2; ++i)
                    if (ks < 2 * (2 * th + i + 1)) acc[i] = __builtin_amdgcn_mfma_f32_32x32x16_bf16(af, __builtin_bit_cast(bf16x8, bfr[i][ks]), acc[i], 0, 0, 0);
            }
        }
#pragma unroll
        for (int i = 0; i < 2; ++i) {
            const int t = 32 * (2 * th + i) + r; bf16* urow = u + (t0 + t) * YP + c0; const float bias = tabs[128 + t];
#pragma unroll
            for (int pq = 0; pq < 2; ++pq) {
                float m8[8];
#pragma unroll
                for (int e = 0; e < 4; ++e) { auto rr = __builtin_amdgcn_permlane32_swap(__float_as_uint(acc[i][8 * pq + e]), __float_as_uint(acc[i][8 * pq + 4 + e]), false, false);
                    m8[e] = __uint_as_float(rr[0]); m8[4 + e] = __uint_as_float(rr[1]); }
                const int d = 32 * db + 16 * pq + 8 * h; const f32x4 s0 = *(const LAS f32x4*)(tabs + d), s1 = *(const LAS f32x4*)(tabs + d + 4);
                const v4u uq = uw[i][pq]; v4u yw;
                yw.x = cvtpk(bflo(uq.x) * (m8[0] * s0[0] + bias), bfhi(uq.x) * (m8[1] * s0[1] + bias));
                yw.y = cvtpk(bflo(uq.y) * (m8[2] * s0[2] + bias), bfhi(uq.y) * (m8[3] * s0[3] + bias));
                yw.z = cvtpk(bflo(uq.z) * (m8[4] * s1[0] + bias), bfhi(uq.z) * (m8[5] * s1[1] + bias));
                yw.w = cvtpk(bflo(uq.w) * (m8[6] * s1[2] + bias), bfhi(uq.w) * (m8[7] * s1[3] + bias));
                *(v4u*)(urow + d) = yw;
            }
        }
        SGU_WRITE(gw, pw, (j + 1) & 1);
#pragma unroll
        for (int i = 0; i < 2; ++i)
#pragma unroll
            for (int pq = 0; pq < 2; ++pq) uw[i][pq] = un[i][pq];
        WG_BAR();
    };
    SGU_LOAD(ga, pa, p0); SGU_LOADU(uw, p0); SGU_LOAD(gb, pb, p0 + min(1, n - 1));
    SGU_WRITE(ga, pa, 0);
    WG_BAR();
    for (int j = 0; j < n; j += 2) { body(j, ga, pa, gb, pb); if (j + 1 < n) body(j + 1, gb, pb, ga, pa); }
#undef SGU_LOAD
#undef SGU_LOADU
#undef SGU_WRITE
}

__device__ __forceinline__ void conv_unit(int ub, bf16* cb  , const bf16* z  , const float* cw  ) {
    const int tid = opaque_tid(), cc = tid & 127, rsub = tid >> 7; const int rbeg = ub * 64 + rsub * 16;
    float w0[8], w1[8], w2[8];
#pragma unroll
    for (int j = 0; j < 2; ++j) { const f32x4 a = *(const f32x4*)(cw + cc * 8 + 4 * j), b_ = *(const f32x4*)(cw + 1024 + cc * 8 + 4 * j), c = *(const f32x4*)(cw + 2048 + cc * 8 + 4 * j);
#pragma unroll
        for (int e = 0; e < 4; ++e) { w0[4 * j + e] = a[e]; w1[4 * j + e] = b_[e]; w2[4 * j + e] = c[e]; } }
    v4u zm2 = (v4u){0u, 0u, 0u, 0u}, zm1 = (v4u){0u, 0u, 0u, 0u};
    if ((rbeg & (SEQ - 1)) != 0) { zm2 = *(const v4u*)(z + (size_t)(rbeg - 2) * 1024 + cc * 8); zm1 = *(const v4u*)(z + (size_t)(rbeg - 1) * 1024 + cc * 8); }
    v4u zr[16], cr[16];
#pragma unroll
    for (int i = 0; i < 16; ++i) { zr[i] = *(const v4u*)(z + (size_t)(rbeg + i) * 1024 + cc * 8); cr[i] = *(const v4u*)(cb + (size_t)(rbeg + i) * YP + cc * 8); }
#pragma unroll
    for (int i = 0; i < 16; ++i) {
        const v4u zc = zr[i], cv = cr[i]; v4u yo;
#pragma unroll
        for (int e = 0; e < 4; ++e) {
            const float ylo = bflo(cv[e]) * (w0[2 * e] * bflo(zm2[e]) + w1[2 * e] * bflo(zm1[e]) + w2[2 * e] * bflo(zc[e]));
            const float yhi = bfhi(cv[e]) * (w0[2 * e + 1] * bfhi(zm2[e]) + w1[2 * e + 1] * bfhi(zm1[e]) + w2[2 * e + 1] * bfhi(zc[e]));
            yo[e] = cvtpk(ylo, yhi);
        }
        *(v4u*)(cb + (size_t)(rbeg + i) * YP + cc * 8) = yo; zm2 = zm1; zm1 = zc;
    }
}

template <int MODE> __device__ __forceinline__ int dst_row(int n0, int row_off) {
    if (MODE == 1) { const int half = n0 >= DFF ? 1 : 0, jj = n0 - half * DFF; return (jj >> 7) * 256 + half * 128 + (jj & 127); }
    if (MODE == 2) { if (n0 < 6144 || n0 >= 8192) return n0; const int cc = n0 - 6144, half = cc >> 10, jj = cc & 1023; return 6144 + (jj >> 7) * 256 + half * 128 + (jj & 127); }
    return n0 + row_off;
}
__device__ __forceinline__ void tr_item(const float* W, int N, bf16* WT, int ldw, int koff, int drow0, const float* gain, LAS float* scr, int k0, int n0, int lane) {
    float v[32];
#pragma unroll
    for (int i = 0; i < 32; ++i) { const int kk = 2 * i + (lane >> 5); v[i] = W[(size_t)(k0 + kk) * N + n0 + (lane & 31)]; }
#pragma unroll
    for (int i = 0; i < 32; ++i) { const int kk = 2 * i + (lane >> 5); scr[kk * 33 + (lane & 31)] = v[i]; }
    LDS_WAIT(); asm volatile("" ::: "memory");
    const int c = lane & 7;
    f32x4 g0 = (f32x4){1.f, 1.f, 1.f, 1.f}, g1 = g0;
    if (gain) { g0 = *(const f32x4*)(gain + k0 + 8 * c); g1 = *(const f32x4*)(gain + k0 + 8 * c + 4); }
#pragma unroll
    for (int j = 0; j < 4; ++j) { const int n = (lane >> 3) + 8 * j; const LAS float* s = scr + (8 * c) * 33 + n;
        v4u o; o.x = cvtpk(s[0 * 33] * g0[0], s[1 * 33] * g0[1]); o.y = cvtpk(s[2 * 33] * g0[2], s[3 * 33] * g0[3]); o.z = cvtpk(s[4 * 33] * g1[0], s[5 * 33] * g1[1]); o.w = cvtpk(s[6 * 33] * g1[2], s[7 * 33] * g1[3]);
        __builtin_nontemporal_store(o, (v4u*)(WT + (size_t)(drow0 + n) * ldw + koff + k0 + 8 * c)); }
    LDS_WAIT(); asm volatile("" ::: "memory");
}
template <int MODE> __device__ __forceinline__ bool conv_try(int& r, const float* W, int K, int N, bf16* WT, int row_off, const float* gain, LAS float* scr, int lane, int ldw = 0, int koff = 0) {
    const int nblk = N / 32, items = (K / 64) * nblk;
    if (r >= items) { r -= items; return false; }
    const int kb = r / nblk, nb = r - kb * nblk, n0 = nb * 32;
    tr_item(W, N, WT, ldw ? ldw : K, koff, dst_row<MODE>(n0, row_off), gain, scr, kb * 64, n0, lane);
    return true;
}
__device__ __forceinline__ void row_to_bf16_ss(const float* xrow, bf16* orow, float* ss_out, int lane) {
    const f32x4* xr = (const f32x4*)xrow + lane; f32x4 v[8]; float s = 0.f;
#pragma unroll
    for (int j = 0; j < 8; ++j) { v[j] = xr[64 * j]; s += (v[j].x * v[j].x + v[j].y * v[j].y) + (v[j].z * v[j].z + v[j].w * v[j].w); }
    s = wave_sum(s);
    u32x2* o8 = (u32x2*)orow + lane;
#pragma unroll
    for (int j = 0; j < 8; ++j) { u32x2 w; w.x = cvtpk(v[j].x, v[j].y); w.y = cvtpk(v[j].z, v[j].w); o8[64 * j] = w; }
    if (lane < 32) ss_out[lane] = (lane == 0) ? s : 0.f;
}

struct Args { const float* in[26]; float* out; unsigned char* ws; int ph_lo, ph_hi; };
constexpr int PH_INIT = 0, PH_KV = 1, PH_L0 = 2, PH_PER_LAYER = 12, PH_FINAL = PH_L0 + DEPTH * PH_PER_LAYER, N_PHASES = PH_FINAL + 1;
enum { I_X = 0, I_MEM, I_F1N, I_F1WI, I_F1WO, I_MIXN, I_MIXWI, I_LAMBDA, I_SUBLN, I_DIFFWO, I_SGUN, I_SGUWS, I_SGUB, I_SGUWO, I_CONVW, I_CONVWO, I_MIXWO, I_XN, I_MEMN, I_XWQ, I_XWKV, I_XWO, I_F2N, I_F2WI, I_F2WO, I_FINALN };

__device__ __forceinline__ int opaque_s(int v) { asm volatile("" : "+s"(v)); return v; }
#define KAS __attribute__((address_space(4)))
__device__ __forceinline__ const KAS char* kargp() { const KAS char* p = (const KAS char*)__builtin_amdgcn_kernarg_segment_ptr(); asm volatile("" : "+s"(p)); return p; }
template <class T> __device__ __forceinline__ T karg(const KAS char* kp, int off) { return *(const KAS T*)(kp + off); }
constexpr int KOFF_OUT = 26 * 8, KOFF_WS = 27 * 8, KOFF_LO = 28 * 8, KOFF_HI = 28 * 8 + 4;
#define PH_ENV const KAS char* kp = kargp(); unsigned char* ws = karg<unsigned char*>(kp, KOFF_WS); (void)ws
#define KIN(i) karg<const float*>(kp, 8 * (i))
#define P_RP(k) ((float*)(ws + WS_RP) + (size_t)(k) * M * 32)
#define P_RPGV(l) ((float*)(ws + WS_RPGV) + (size_t)(l) * M * 16)
#define P_RPMEM ((float*)(ws + WS_RPMEM))
#define P_TAB ((LAS float*)(lds + RSTAB_OFF))
#define P_WL(lay, off) ((bf16*)(ws + (((lay) & 1) ? WS_W1 : WS_W) + (off)))
#define P_W(off) P_WL(l, off)
#define P_WXKV ((bf16*)(ws + WS_WXKV))
#define P_HB ((bf16*)(ws + WS_HB))
#define P_MEMB ((bf16*)(ws + WS_MEMB))
#define P_KVX ((bf16*)(ws + WS_KVX))
#define P_QX ((bf16*)(ws + WS_QX))
#define P_HID ((bf16*)(ws + WS_HID))
#define P_QUC ((bf16*)(ws + WS_QUC))
#define P_KV2 ((bf16*)(ws + WS_KV2))
#define P_GVZ ((bf16*)(ws + WS_GVZ))
#define P_GATES ((bf16*)(ws + WS_GATES))
#define P_MERGED ((bf16*)(ws + WS_H))

__global__ void __launch_bounds__(NTHREADS, 2) fwd_kernel(Args args_unused) {
    extern __shared__ __attribute__((aligned(16))) unsigned char lds_raw[];
    LAS unsigned char* lds = (LAS unsigned char*)lds_raw;
    volatile LAS unsigned* MISC = (volatile LAS unsigned*)(lds + MISC_OFF);
    const int G = gridDim.x, bx = blockIdx.x, vcu = (G % 8 == 0) ? (bx % 8) * (G / 8) + bx / 8 : bx;
    { const int tid0 = opaque_tid(); for (int u = tid0; u < (LDS_BYTES - LDSCTL_OFF) / 4; u += NTHREADS) ((LAS unsigned*)(lds + LDSCTL_OFF))[u] = 0u; }
    __syncthreads();
    int lo, hi; XcdBarrier bar;
    { PH_ENV; lo = karg<int>(kp, KOFF_LO); hi = karg<int>(kp, KOFF_HI);
      bar.bar = (unsigned*)(ws + WS_CTL) + 4096; bar.x = 0; bar.st = nullptr;
      if (hi - lo > 1) { bar = xcd_barrier_post((unsigned*)(ws + WS_CTL) + 4096, MISC + 8);
          if (threadIdx.x == 0) { unsigned* vw = (unsigned*)(ws + WS_CTL) + 9100; if (G != 256) xb_add(vw, 1u);
              __hip_atomic_fetch_max(vw + 4 + 2 * (bx & 7), bar.x + 1u, RLX_AGENT); __hip_atomic_fetch_max(vw + 5 + 2 * (bx & 7), 16u - bar.x, RLX_AGENT); } } }
#define IN(k) (lo <= (k) && (k) < hi)
#define SEAM(k) do { if (IN(k) && IN((k) + 1)) xcd_barrier(bar); } while (0)
#define SEAM_LOCAL(k) do { if (IN(k) && IN((k) + 1)) { if (MISC[15] == 1u) xcd_barrier_local(bar); else xcd_barrier(bar); } } while (0)
    constexpr size_t PL = (size_t)M * 1024;
    const int NGW = G * NWAVES;
#define WAVE_ENV const int tid = opaque_tid(), lane = tid & 63, wave = __builtin_amdgcn_readfirstlane(tid >> 6), gw = vcu * NWAVES + wave; LAS float* scr = (LAS float*)(lds + RING_OFF + wave * 16384); (void)lane; (void)gw; (void)scr

#define PREP_LAYER(l) do { \
        const float* f1wi = KIN(I_F1WI) + (size_t)(l) * D * NFFIN; const float* f1wo = KIN(I_F1WO) + (size_t)(l) * DFF * D; \
        const float* f2wi = KIN(I_F2WI) + (size_t)(l) * D * NFFIN; const float* f2wo = KIN(I_F2WO) + (size_t)(l) * DFF * D; \
        const float* mwi = KIN(I_MIXWI) + (size_t)(l) * D * NMIX; const float* dwo = KIN(I_DIFFWO) + (size_t)(l) * 1024 * D; const float* swo = KIN(I_SGUWO) + (size_t)(l) * 1024 * D; \
        const float* cwo = KIN(I_CONVWO) + (size_t)(l) * 1024 * D; const float* mwo = KIN(I_MIXWO) + (size_t)(l) * D * D; const float* xwq = KIN(I_XWQ) + (size_t)(l) * D * 512; const float* xwo = KIN(I_XWO) + (size_t)(l) * 512 * D; \
        constexpr int NIT = 2 * ((D / 64) * (NFFIN / 32) + (DFF / 64) * (D / 32)) + (D / 64) * (NMIX / 32) + 3 * (1024 / 64) * (D / 32) + (D / 64) * (D / 32) + (D / 64) * (512 / 32) + (512 / 64) * (D / 32); \
        for (int it = gw; it < NIT; it += NGW) { int r_ = it; \
            if (conv_try<1>(r_, f1wi, D, NFFIN, P_WL((l), W_F1IN), 0, KIN(I_F1N) + (l) * D, scr, lane)) continue; \
            if (conv_try<1>(r_, f2wi, D, NFFIN, P_WL((l), W_F2IN), 0, KIN(I_F2N) + (l) * D, scr, lane)) continue; \
            if (conv_try<2>(r_, mwi, D, NMIX, P_WL((l), W_MIXIN), 0, KIN(I_MIXN) + (l) * D, scr, lane)) continue; \
            if (conv_try<0>(r_, f1wo, DFF, D, P_WL((l), W_F1OUT), 0, nullptr, scr, lane)) continue; \
            if (conv_try<0>(r_, f2wo, DFF, D, P_WL((l), W_F2OUT), 0, nullptr, scr, lane)) continue; \
            if (conv_try<0>(r_, dwo, 1024, D, P_WL((l), W_BR3), 0, nullptr, scr, lane, 3072, 0)) continue; \
            if (conv_try<0>(r_, swo, 1024, D, P_WL((l), W_BR3), 0, nullptr, scr, lane, 3072, 1024)) continue; \
            if (conv_try<0>(r_, cwo, 1024, D, P_WL((l), W_BR3), 0, nullptr, scr, lane, 3072, 2048)) continue; \
            if (conv_try<0>(r_, mwo, D, D, P_WL((l), W_MO), 0, nullptr, scr, lane)) continue; \
            if (conv_try<0>(r_, xwq, D, 512, P_WL((l), W_XQ), 0, KIN(I_XN) + (l) * D, scr, lane)) continue; \
            conv_try<0>(r_, xwo, 512, D, P_WL((l), W_XO), 0, nullptr, scr, lane); } } while (0)

    if (IN(PH_INIT)) { PH_ENV; WAVE_ENV;
        for (int m = gw; m < M; m += NGW) row_to_bf16_ss(KIN(I_X) + (size_t)m * D, P_HB + (size_t)m * D, P_RP(0) + (size_t)m * 32, lane);
        for (int m = gw; m < MMEM; m += NGW) row_to_bf16_ss(KIN(I_MEM) + (size_t)m * D, P_MEMB + (size_t)m * D, P_RPMEM + (size_t)m * 32, lane);
        { constexpr int NIT = DEPTH * (D / 64) * (1024 / 32);
          for (int it = gw; it < NIT; it += NGW) { int r_ = it;
#pragma unroll
              for (int l = 0; l < DEPTH; ++l) if (conv_try<0>(r_, KIN(I_XWKV) + (size_t)l * D * 1024, D, 1024, P_WXKV, l * 1024, KIN(I_MEMN) + l * D, scr, lane)) break; } }
        { PH_ENV; WAVE_ENV; PREP_LAYER(0); }
    }
    SEAM(PH_INIT);
    if (IN(PH_INIT) && IN(PH_INIT + 1)) { PH_ENV; if (threadIdx.x == 0) { unsigned* vw = (unsigned*)(ws + WS_CTL) + 9100; bool ok = xb_ld(vw) == 0u; unsigned seen = 0u;
            for (int r8 = 0; r8 < 8; ++r8) { const unsigned mx = xb_ld(vw + 4 + 2 * r8), mn = xb_ld(vw + 5 + 2 * r8); ok = ok && mx >= 1u && (mx - 1u) == (16u - mn) && !((seen >> (mx - 1u)) & 1u); seen |= 1u << ((mx - 1u) & 15u); }
            MISC[15] = ok ? 1u : 0u; } __syncthreads(); }
    if (IN(PH_KV)) { PH_ENV;
        pg8::Gemm g{P_MEMB, P_WXKV, MMEM, 4096, D}; KvOrder S{G, opaque_s(vcu)};
        ep::EpiScale E{P_RPMEM, P_TAB, P_KVX, 4096, 1.0f};
        pg8::gemm_phase<ep::EpiScale, KvOrder, true, true>(lds + RING_OFF, g, S, E);
    }
    if (IN(PH_KV) && IN(PH_KV + 1)) { if (MISC[15] == 1u) __syncthreads(); else xcd_barrier(bar); }

    for (int l = 0; l < DEPTH; ++l) {
        const int P = PH_L0 + l * PH_PER_LAYER;
        if (l > 0) SEAM(P + 0);
        if (IN(P + 1)) { PH_ENV;
            pg8::Gemm g{P_HB, P_W(W_F1IN), M, NFFIN, D}; pg8::StaticOrder S; S.init(M, NFFIN, G, opaque_s(bx));
            ep::EpiFfnIn E{P_RP(4 * l + 0), P_TAB, P_HID};
            pg8::gemm_phase<ep::EpiFfnIn, pg8::StaticOrder, true, true>(lds + RING_OFF, g, S, E);
        }
        SEAM_LOCAL(P + 1);
        if (IN(P + 2)) { PH_ENV;
            pg8::Gemm g{P_HID, P_W(W_F1OUT), M, D, DFF, HID_SLOTS}; pg8::StaticOrder S; S.init(M, D, G, opaque_s(bx));
            ep::EpiResidNT E{P_HB, P_RP(4 * l + 1), 0.5f};
            pg8::gemm_phase<ep::EpiResidNT, pg8::StaticOrder, true, true>(lds + RING_OFF, g, S, E);
        }
        SEAM_LOCAL(P + 2);
        if (IN(P + 3)) { PH_ENV;
            pg8::Gemm g{P_HB, P_W(W_MIXIN), M, NMIX, D}; pg8::StaticOrder S; S.init(M, NMIX, G, opaque_s(bx));
            ep::EpiMixIn E{P_RP(4 * l + 1), P_TAB, P_RPGV(l), P_QUC, P_KV2, P_GVZ, P_GATES};
            pg8::gemm_phase<ep::EpiMixIn, pg8::StaticOrder, true, true>(lds + RING_OFF, g, S, E);
        }
        SEAM_LOCAL(P + 3);
        if (IN(P + 4)) { PH_ENV; WAVE_ENV;
            LAS float* lamp = (LAS float*)(lds + RING_OFF + 65536);
            const float lam_init = 0.8f - 0.6f * expf(-0.3f * (float)l);
            if (wave == 0) { const float* lp = KIN(I_LAMBDA) + l * 256; const float a = wave_sum(lp[lane] * lp[64 + lane]), b_ = wave_sum(lp[128 + lane] * lp[192 + lane]);
                if (lane == 0) lamp[0] = expf(a) - expf(b_) + lam_init; }
            WG_BAR();
            const float lam = lamp[0];
            WG_BAR();
            int bxl = bx; asm volatile("" : "+s"(bxl));
            for (int part = 0; part < 2; ++part) {
                if ((part == 0) == (((bxl >> 4) & 1) == 0)) {
            LAS float* gnl = (LAS float*)(lds + RING_OFF + 67584);
            if (tid < 128) gnl[tid] = (KIN(I_SUBLN) + l * 128)[tid];
            WG_BAR();
            for (int i = 0; i < 4; ++i) {
                for (int uu = vcu; uu < 256; uu += G) {
                    const int bh = uu >> 1, s = uu & 1; const int qb = (i == 0) ? s : (i == 1) ? 7 - s : (i == 2) ? 2 + s : 5 - s;
                    diff_attn_unit(bh >> 3, bh & 7, qb, P_QUC, P_KV2, P_KV2 + PL, gnl, lam, 1.0f - lam_init, lds + RING_OFF);
                }
            }
                } else {
            for (int uu = vcu; uu < 256; uu += G) sgu_run(uu & 7, (uu >> 3) * 8, 8, P_QUC + 1024, P_GVZ, P_RPGV(l), KIN(I_SGUWS) + (size_t)l * 8 * 128 * 128, KIN(I_SGUB) + l * 8 * 128, KIN(I_SGUN) + l * 1024, lds + RING_OFF);
            for (int uu = vcu; uu < M / 128; uu += G) { conv_unit(2 * uu, P_QUC + 2048, P_GVZ + PL, KIN(I_CONVW) + l * 3 * 1024); conv_unit(2 * uu + 1, P_QUC + 2048, P_GVZ + PL, KIN(I_CONVW) + l * 3 * 1024); }
            if (l + 1 < DEPTH) { { PH_ENV; WAVE_ENV; PREP_LAYER(l + 1); } WG_BAR(); }
                }
            }
        }
        SEAM_LOCAL(P + 4);
        if (IN(P + 5)) { PH_ENV;
            pg8::Gemm g{P_QUC, P_W(W_BR3), M, D, 3072}; pg8::StaticOrder S; S.init(M, D, G, opaque_s(bx));
            ep::EpiMerge E{P_GATES, P_MERGED};
            pg8::gemm_phase<ep::EpiMerge, pg8::StaticOrder, true, true>(lds + RING_OFF, g, S, E);
        }
        SEAM_LOCAL(P + 5);
        if (IN(P + 6)) { PH_ENV;
            pg8::Gemm g{P_MERGED, P_W(W_MO), M, D, D}; pg8::StaticOrder S; S.init(M, D, G, opaque_s(bx));
            ep::EpiResidNT E{P_HB, P_RP(4 * l + 2), 1.0f};
            pg8::gemm_phase<ep::EpiResidNT, pg8::StaticOrder, true, true>(lds + RING_OFF, g, S, E);
        }
        SEAM_LOCAL(P + 6);
        if (IN(P + 7)) { PH_ENV;
            pg8::Gemm g{P_HB, P_W(W_XQ), M, 512, D}; pg8::StaticOrder S; S.init(M, 512, G, opaque_s(bx));
            ep::EpiScale E{P_RP(4 * l + 2), P_TAB, P_QX, 512, QSCALE_MEM};
            pg8::gemm_phase<ep::EpiScale, pg8::StaticOrder, true, true>(lds + RING_OFF, g, S, E);
            pg8::Unit uq;
            for (int i = 0; S.next(i, uq); ++i)
                for (int j = 0; j < 2; ++j) mem_attn_unit(uq.pm >> 3, 2 * uq.pn + j, uq.pm & 7, P_QX, P_KVX + l * 1024, lds + RING_OFF);
        }
        SEAM_LOCAL(P + 7);
        if (IN(P + 9)) { PH_ENV;
            pg8::Gemm g{P_QX, P_W(W_XO), M, D, 512}; pg8::StaticOrder S; S.init(M, D, G, opaque_s(bx));
            ep::EpiResid E{P_HB, P_RP(4 * l + 3), 1.0f};
            pg8::gemm_phase<ep::EpiResid, pg8::StaticOrder, true, true>(lds + RING_OFF, g, S, E);
        }
        SEAM_LOCAL(P + 9);
        if (IN(P + 10)) { PH_ENV;
            pg8::Gemm g{P_HB, P_W(W_F2IN), M, NFFIN, D}; pg8::StaticOrder S; S.init(M, NFFIN, G, opaque_s(bx));
            ep::EpiFfnIn E{P_RP(4 * l + 3), P_TAB, P_HID};
            pg8::gemm_phase<ep::EpiFfnIn, pg8::StaticOrder, true, true>(lds + RING_OFF, g, S, E);
        }
        SEAM_LOCAL(P + 10);
        if (IN(P + 11)) { PH_ENV;
            pg8::Gemm g{P_HID, P_W(W_F2OUT), M, D, DFF, HID_SLOTS}; pg8::StaticOrder S; S.init(M, D, G, opaque_s(bx));
            ep::EpiResidNT E{P_HB, P_RP(4 * l + 4), 0.5f};
            pg8::gemm_phase<ep::EpiResidNT, pg8::StaticOrder, true, true>(lds + RING_OFF, g, S, E);
        }
        if (l == DEPTH - 1) SEAM_LOCAL(P + 11);
    }
    if (IN(PH_FINAL)) { PH_ENV; WAVE_ENV;
        const float* rp16 = P_RP(16); const float* gfin = KIN(I_FINALN);
        const bool xa = (G == 256); const int m0 = xa ? (vcu >> 5) * (M / 8) + (vcu & 31) * NWAVES + wave : gw, mstep = xa ? 32 * NWAVES : NGW, mend = xa ? ((vcu >> 5) + 1) * (M / 8) : M;
        for (int m = m0; m < mend; m += mstep) {
            const float ssum = wave_sum(lane < 32 ? rp16[(size_t)m * 32 + lane] : 0.f);
            const float rstd = rsqf_(ssum * (1.0f / D) + EPS);
            const u32x2* hr = (const u32x2*)(P_HB + (size_t)m * D) + lane; f32x4* orow = (f32x4*)(karg<float*>(kp, KOFF_OUT) + (size_t)m * D) + lane; const f32x4* gr = (const f32x4*)gfin + lane;
#pragma unroll
            for (int j = 0; j < 8; ++j) { const u32x2 h2 = hr[64 * j]; orow[64 * j] = (f32x4){bflo(h2.x), bfhi(h2.x), bflo(h2.y), bfhi(h2.y)} * rstd * gr[64 * j]; }
        }
    }
#undef IN
#undef SEAM
#undef SEAM_LOCAL
#undef PREP_LAYER
}

#ifndef MK_SPLIT
#define MK_SPLIT 0
#endif
extern "C" void kernel_launch(void* const* d_in, const int* in_sizes, int n_in, void* d_out, int out_size, void* d_ws, size_t ws_size, hipStream_t stream) {
    static int grid = 0;
    if (grid == 0) {
        if (n_in != 26 || out_size != M * D || ws_size < WS_END) { fprintf(stderr, "kernel_launch: unexpected shapes: n_in %d out %d ws %zu (need %zu)\n", n_in, out_size, ws_size, (size_t)WS_END); grid = -1; return; }
        int dev = 0, cus = 0, per_cu = 0;
        if (hipGetDevice(&dev) != hipSuccess || hipDeviceGetAttribute(&cus, hipDeviceAttributeMultiprocessorCount, dev) != hipSuccess) { grid = -1; return; }
        if (hipFuncSetAttribute((const void*)fwd_kernel, hipFuncAttributeMaxDynamicSharedMemorySize, LDS_BYTES) != hipSuccess) { fprintf(stderr, "kernel_launch: hipFuncSetAttribute failed\n"); grid = -1; return; }
        if (hipOccupancyMaxActiveBlocksPerMultiprocessor(&per_cu, (const void*)fwd_kernel, NTHREADS, LDS_BYTES) != hipSuccess || per_cu < 1) fprintf(stderr, "kernel_launch: occupancy query says %d\n", per_cu);
        (void)hipGetLastError();
        grid = cus;
    }
    if (grid < 0) return;
    (void)in_sizes;
    if (hipMemsetAsync((char*)d_ws, 0, ZERO_BYTES, stream) != hipSuccess) { fprintf(stderr, "kernel_launch: memset failed\n"); return; }
    Args a{};
    for (int i = 0; i < 26; ++i) a.in[i] = (const float*)d_in[i];
    a.out = (float*)d_out; a.ws = (unsigned char*)d_ws;
#if MK_SPLIT
    for (int p = 0; p < N_PHASES; ++p) { a.ph_lo = p; a.ph_hi = p + 1; hipLaunchKernelGGL(fwd_kernel, dim3(grid), dim3(NTHREADS), LDS_BYTES, stream, a); }
#else
    a.ph_lo = 0; a.ph_hi = N_PHASES;
    hipLaunchKernelGGL(fwd_kernel, dim3(grid), dim3(NTHREADS), LDS_BYTES, stream, a);
#endif
    const hipError_t le = hipPeekAtLastError();
    if (le != hipSuccess) fprintf(stderr, "kernel_launch: launch failed: %s\n", hipGetErrorName(le));
}
```
